# Optimizing an MI355X kernel written in HIP

```python
import jax, jax.numpy as jnp
from jax import lax
import numpy as np

D_MODEL = 1024
BATCH = 8
SEQ = 2048
DEPTH = 2

PLE_DIM = 256
D_A = D_MODEL // 2
NH_A = 8
G_A = 2
HPG_A = NH_A // G_A
DK_A = D_A // NH_A
KV_A = G_A * DK_A
L_CMP = 32
STRIDE_CMP = 16
CMP_HID = 128
L_SEL = 64
N_SEL = 8
WINDOW = 256
Q_BLOCK = 128
BIG = 1e9
D_B = D_MODEL // 2
CHUNK_B = 128
G_B = 4
CH_B = D_B // G_B
D_C = D_MODEL // 2
NH_C = 4
DH_C = D_C // NH_C
CONV_W = 4
CHUNK_C = 128
N_BRANCH = 3
ALPHA = (2.0 * DEPTH) ** 0.25
BETA = (8.0 * DEPTH) ** -0.25
LN_EPS = 1e-5
IN_SIZES = (D_A, KV_A, KV_A, KV_A, KV_A, KV_A, KV_A, 3 * NH_A, D_A,
            D_B, D_B, D_B,
            D_C, D_C, D_C, 2 * NH_C, D_C, D_C,
            N_BRANCH * D_MODEL)
N_IN = sum(IN_SIZES)

kernel_name = 'hybrid_nsa_gmlp_mlstm'


def _layernorm(x, g, b):
    xf = x.astype(jnp.float32)
    mu = jnp.mean(xf, -1, keepdims=True)
    var = jnp.mean(jnp.square(xf - mu), -1, keepdims=True)
    return ((xf - mu) * lax.rsqrt(var + LN_EPS) * g + b).astype(x.dtype)


def _masked_softmax(s, mask):
    s = jnp.where(mask, s, -jnp.inf)
    m = jnp.max(s, axis=-1, keepdims=True)
    m = jnp.where(jnp.isfinite(m), m, 0.0)
    e = jnp.where(mask, jnp.exp(s - m), 0.0)
    return e / jnp.maximum(jnp.sum(e, -1, keepdims=True), 1e-30)


def _alibi_slopes(n):
    return 2.0 ** (-8.0 * jnp.arange(1, n + 1, dtype=jnp.float32) / n)


def _nsa(q, kc, vc, ks, vs, kw, vw, g, pos_k, pos_v, wk1, wk2, wv1, wv2):
    bsz, t_len, _ = q.shape
    f32 = jnp.float32
    qh = (q * DK_A ** -0.5).reshape(bsz, t_len, G_A, HPG_A, DK_A).transpose(0, 2, 3, 1, 4)
    slopes = _alibi_slopes(NH_A).reshape(G_A, HPG_A, 1, 1)
    tpos = jnp.arange(t_len)

    def kv_heads(z):
        return z.reshape(bsz, t_len, G_A, DK_A)

    n_cmp = (t_len - L_CMP) // STRIDE_CMP + 1
    cmp_start = jnp.arange(n_cmp) * STRIDE_CMP
    blk = cmp_start[:, None] + jnp.arange(L_CMP)[None, :]

    def compress(z, pos, w1, w2):
        zb = kv_heads(z)[:, blk] + pos[:, None, :]
        zb = zb.transpose(0, 1, 3, 2, 4).reshape(bsz, n_cmp, G_A, L_CMP * DK_A)
        return (jax.nn.gelu(zb @ w1) @ w2).transpose(0, 2, 1, 3)

    k_cmp = compress(kc, pos_k, wk1, wk2)
    v_cmp = compress(vc, pos_v, wv1, wv2)
    d_cmp = tpos[:, None] - (cmp_start + L_CMP - 1)[None, :]
    s_cmp = jnp.einsum('bghtd,bgnd->bghtn', qh, k_cmp).astype(f32) - slopes * d_cmp
    p_cmp = _masked_softmax(s_cmp, d_cmp >= 0)
    o_cmp = jnp.einsum('bghtn,bgnd->bghtd', p_cmp.astype(v_cmp.dtype), v_cmp)

    n_blk = t_len // L_SEL
    sel_start = jnp.arange(n_blk) * L_SEL
    overlap = ((cmp_start[:, None] < sel_start[None, :] + L_SEL)
               & (cmp_start[:, None] + L_CMP > sel_start[None, :])).astype(f32)
    imp = jnp.einsum('bghtn,nj->bgtj', p_cmp, overlap)
    cur = (tpos // L_SEL)[:, None]
    jb = jnp.arange(n_blk)[None, :]
    forced = (jb == 0) | (jb == cur) | (jb == cur - 1)
    score = jnp.where(jb <= cur, jnp.where(forced, BIG, imp), -BIG)
    k_top = min(N_SEL, n_blk)
    top_score, top_idx = lax.top_k(score, k_top)
    top_valid = top_score > -0.5 * BIG
    n_tok = k_top * L_SEL

    ks_h = kv_heads(ks).transpose(0, 2, 1, 3)
    vs_h = kv_heads(vs).transpose(0, 2, 1, 3)
    pad = ((0, 0), (0, 0), (WINDOW, 0), (0, 0))
    kw_h = jnp.pad(kv_heads(kw).transpose(0, 2, 1, 3), pad)
    vw_h = jnp.pad(kv_heads(vw).transpose(0, 2, 1, 3), pad)

    def query_block(qb):
        t0 = qb * Q_BLOCK
        tq = t0 + jnp.arange(Q_BLOCK)
        q_blk = lax.dynamic_slice_in_dim(qh, t0, Q_BLOCK, axis=3)
        idx = lax.dynamic_slice_in_dim(top_idx, t0, Q_BLOCK, axis=2)
        val = lax.dynamic_slice_in_dim(top_valid, t0, Q_BLOCK, axis=2)
        tok = (idx[..., None] * L_SEL + jnp.arange(L_SEL)).reshape(bsz, G_A, Q_BLOCK, n_tok)
        m_sel = jnp.repeat(val, L_SEL, axis=-1) & (tok <= tq[:, None])
        flat = tok.reshape(bsz, G_A, Q_BLOCK * n_tok, 1)
        k_g = jnp.take_along_axis(ks_h, flat, axis=2).reshape(bsz, G_A, Q_BLOCK, n_tok, DK_A)
        v_g = jnp.take_along_axis(vs_h, flat, axis=2).reshape(bsz, G_A, Q_BLOCK, n_tok, DK_A)
        d_sel = (tq[:, None] - tok)[:, :, None]
        s_sel = jnp.einsum('bghqd,bgqsd->bghqs', q_blk, k_g).astype(f32) - slopes * d_sel
        p_sel = _masked_softmax(s_sel, m_sel[:, :, None])
        o_sel = jnp.einsum('bghqs,bgqsd->bghqd', p_sel.astype(v_g.dtype), v_g)
        k_w = lax.dynamic_slice_in_dim(kw_h, t0, WINDOW + Q_BLOCK, axis=2)
        v_w = lax.dynamic_slice_in_dim(vw_h, t0, WINDOW + Q_BLOCK, axis=2)
        sk = t0 - WINDOW + jnp.arange(WINDOW + Q_BLOCK)
        d_w = tq[:, None] - sk[None, :]
        m_w = (d_w >= 0) & (d_w < WINDOW) & (sk[None, :] >= 0)
        s_w = jnp.einsum('bghqd,bgkd->bghqk', q_blk, k_w).astype(f32) - slopes * d_w
        p_w = _masked_softmax(s_w, m_w)
        o_w = jnp.einsum('bghqk,bgkd->bghqd', p_w.astype(v_w.dtype), v_w)
        return o_sel, o_w

    o_sel, o_win = lax.map(query_block, jnp.arange(t_len // Q_BLOCK))
    o_sel = o_sel.transpose(1, 2, 3, 0, 4, 5).reshape(bsz, G_A, HPG_A, t_len, DK_A)
    o_win = o_win.transpose(1, 2, 3, 0, 4, 5).reshape(bsz, G_A, HPG_A, t_len, DK_A)
    gates = jax.nn.sigmoid(g).reshape(bsz, t_len, 3, G_A, HPG_A).transpose(2, 0, 3, 4, 1)[..., None]
    o = gates[0] * o_cmp + gates[1] * o_sel + gates[2] * o_win
    return o.transpose(0, 3, 1, 2, 4).reshape(bsz, t_len, D_A)


def _spatial_gating(u, v, ln_g, ln_b, w_s, b_s):
    bsz, t_len, _ = u.shape
    u = jax.nn.gelu(u)
    v = _layernorm(jax.nn.gelu(v), ln_g, ln_b)
    v = v.reshape(bsz, t_len // CHUNK_B, CHUNK_B, G_B, CH_B)
    w = w_s * jnp.tril(jnp.ones((CHUNK_B, CHUNK_B), w_s.dtype))
    mixed = jnp.einsum('gts,bcsge->bctge', w, v) + b_s.T[:, :, None]
    return u * mixed.reshape(bsz, t_len, D_B)


def _mlstm(q, k, v, gif, o, conv_w, conv_b, b_i, b_f, norm_g):
    bsz, t_len, _ = q.shape
    dt = q.dtype
    f32 = jnp.float32
    qk = jnp.concatenate([q, k], -1)
    qk = lax.conv_general_dilated(qk, conv_w[:, None, :], window_strides=(1,), padding=[(CONV_W - 1, 0)],
                                  dimension_numbers=('NWC', 'WIO', 'NWC'), feature_group_count=2 * D_C) + conv_b
    q, k = jnp.split(jax.nn.silu(qk), 2, axis=-1)
    nc = t_len // CHUNK_C

    def hc(z):
        return z.reshape(bsz, nc, CHUNK_C, NH_C, DH_C).transpose(0, 3, 1, 2, 4).astype(f32)

    def hg(z):
        return z.reshape(bsz, nc, CHUNK_C, NH_C).transpose(0, 3, 1, 2)

    qh, kh, vh = hc(q), hc(k) * DH_C ** -0.5, hc(v)
    gi, gf = jnp.split(gif.astype(f32), 2, axis=-1)
    log_i = hg(gi + b_i)
    log_f = jax.nn.log_sigmoid(hg(gf + b_f))
    bcum = jnp.cumsum(log_f, axis=-1)
    b_last = bcum[..., -1]
    causal = jnp.tril(jnp.ones((CHUNK_C, CHUNK_C), bool))
    dmat = jnp.where(causal, bcum[..., :, None] - bcum[..., None, :] + log_i[..., None, :], -jnp.inf)
    w_end = b_last[..., None] - bcum + log_i
    m_loc = jnp.max(w_end, -1)
    e_end = jnp.exp(w_end - m_loc[..., None])
    c_loc = jnp.einsum('bhcs,bhcsv,bhcsk->bhcvk', e_end, vh, kh)
    n_loc = jnp.einsum('bhcs,bhcsk->bhck', e_end, kh)

    def step(carry, xs):
        c_st, n_st, m_st = carry
        cl, nl, ml, bl = xs
        m_new = jnp.maximum(bl + m_st, ml)
        a = jnp.exp(bl + m_st - m_new)
        bb = jnp.exp(ml - m_new)
        c_new = a[..., None, None] * c_st + bb[..., None, None] * cl
        n_new = a[..., None] * n_st + bb[..., None] * nl
        return (c_new, n_new, m_new), (c_st, n_st, m_st)

    init = (jnp.zeros((bsz, NH_C, DH_C, DH_C), f32), jnp.zeros((bsz, NH_C, DH_C), f32), jnp.zeros((bsz, NH_C), f32))
    xs = (c_loc.transpose(2, 0, 1, 3, 4), n_loc.transpose(2, 0, 1, 3), m_loc.transpose(2, 0, 1), b_last.transpose(2, 0, 1))
    _, (c_prev, n_prev, m_prev) = lax.scan(step, init, xs)
    c_prev = c_prev.transpose(1, 2, 0, 3, 4)
    n_prev = n_prev.transpose(1, 2, 0, 3)
    m_prev = m_prev.transpose(1, 2, 0)
    inter = bcum + m_prev[..., None]
    m_t = jnp.maximum(inter, jnp.max(dmat, -1))
    s = jnp.einsum('bhctd,bhcsd->bhcts', qh, kh) * jnp.exp(dmat - m_t[..., None])
    e_int = jnp.exp(inter - m_t)
    num = jnp.einsum('bhcts,bhcsv->bhctv', s, vh) + e_int[..., None] * jnp.einsum('bhcvk,bhctk->bhctv', c_prev, qh)
    den = jnp.sum(s, -1) + e_int * jnp.einsum('bhck,bhctk->bhct', n_prev, qh)
    h = num / jnp.maximum(jnp.abs(den), jnp.exp(-m_t))[..., None]
    mu = jnp.mean(h, -1, keepdims=True)
    var = jnp.mean(jnp.square(h - mu), -1, keepdims=True)
    hn = ((h - mu) * lax.rsqrt(var + LN_EPS)).transpose(0, 2, 3, 1, 4).reshape(bsz, t_len, D_C) * norm_g
    return (hn * jax.nn.sigmoid(o.astype(f32))).astype(dt)


def setup_inputs(seed: int = 0) -> dict:
    key = jax.random.key(seed)
    ks = jax.random.split(key, 32)
    f32 = jnp.float32

    def nrm(k, shape, scale):
        return jax.random.normal(k, shape, f32) * scale

    return {
        'x': nrm(ks[0], (BATCH, SEQ, D_MODEL), 1.0),
        'p': nrm(ks[1], (DEPTH, BATCH, SEQ, PLE_DIM), 1.0),
        'w_in': nrm(ks[2], (DEPTH, D_MODEL, N_IN), D_MODEL ** -0.5),
        'cmp_pos_k': nrm(ks[3], (DEPTH, L_CMP, DK_A), 0.1),
        'cmp_pos_v': nrm(ks[4], (DEPTH, L_CMP, DK_A), 0.1),
        'cmp_wk1': nrm(ks[5], (DEPTH, L_CMP * DK_A, CMP_HID), (L_CMP * DK_A) ** -0.5),
        'cmp_wk2': nrm(ks[6], (DEPTH, CMP_HID, DK_A), CMP_HID ** -0.5),
        'cmp_wv1': nrm(ks[7], (DEPTH, L_CMP * DK_A, CMP_HID), (L_CMP * DK_A) ** -0.5),
        'cmp_wv2': nrm(ks[8], (DEPTH, CMP_HID, DK_A), CMP_HID ** -0.5),
        'sg_ln_g': 1.0 + nrm(ks[9], (DEPTH, D_B), 0.02),
        'sg_ln_b': nrm(ks[10], (DEPTH, D_B), 0.02),
        'sg_w': nrm(ks[11], (DEPTH, G_B, CHUNK_B, CHUNK_B), CHUNK_B ** -0.5),
        'sg_b': 1.0 + nrm(ks[12], (DEPTH, G_B, CHUNK_B), 0.02),
        'ml_conv_w': nrm(ks[13], (DEPTH, CONV_W, 2 * D_C), CONV_W ** -0.5),
        'ml_conv_b': nrm(ks[14], (DEPTH, 2 * D_C), 0.02),
        'ml_b_i': nrm(ks[15], (DEPTH, NH_C), 0.1),
        'ml_b_f': jnp.linspace(3.0, 6.0, NH_C, dtype=f32)[None, :] + nrm(ks[16], (DEPTH, NH_C), 0.1),
        'ml_norm_g': 1.0 + nrm(ks[17], (DEPTH, D_C), 0.02),
        'w_br_a': nrm(ks[18], (DEPTH, D_A, D_MODEL), BETA * D_A ** -0.5),
        'w_br_b': nrm(ks[19], (DEPTH, D_B, D_MODEL), BETA * D_B ** -0.5),
        'w_br_c': nrm(ks[20], (DEPTH, D_C, D_MODEL), BETA * D_C ** -0.5),
        'w_out': nrm(ks[21], (DEPTH, D_MODEL, D_MODEL), BETA * D_MODEL ** -0.5),
        'ple_w': nrm(ks[22], (DEPTH, PLE_DIM, D_MODEL), BETA * PLE_DIM ** -0.5),
        'ple_gate': nrm(ks[23], (DEPTH, D_MODEL, D_MODEL), D_MODEL ** -0.5),
        'ln_g': 1.0 + nrm(ks[24], (DEPTH, D_MODEL), 0.02),
        'ln_b': nrm(ks[25], (DEPTH, D_MODEL), 0.02),
    }


def reference(x, p, w_in, cmp_pos_k, cmp_pos_v, cmp_wk1, cmp_wk2, cmp_wv1, cmp_wv2,
              sg_ln_g, sg_ln_b, sg_w, sg_b, ml_conv_w, ml_conv_b, ml_b_i, ml_b_f, ml_norm_g,
              w_br_a, w_br_b, w_br_c, w_out, ple_w, ple_gate, ln_g, ln_b):
    bsz, t_len = x.shape[0], x.shape[1]
    split_at = np.cumsum(IN_SIZES)[:-1].tolist()
    for i in range(DEPTH):
        (a_q, a_kc, a_vc, a_ks, a_vs, a_kw, a_vw, a_g, a_z,
         b_u, b_v, b_z,
         c_q, c_k, c_v, c_if, c_o, c_z, m_g) = jnp.split(x @ w_in[i], split_at, axis=-1)
        y_a = _nsa(a_q, a_kc, a_vc, a_ks, a_vs, a_kw, a_vw, a_g, cmp_pos_k[i], cmp_pos_v[i],
                   cmp_wk1[i], cmp_wk2[i], cmp_wv1[i], cmp_wv2[i]) * jax.nn.silu(a_z)
        y_b = _spatial_gating(b_u, b_v, sg_ln_g[i], sg_ln_b[i], sg_w[i], sg_b[i]) * jax.nn.silu(b_z)
        y_c = _mlstm(c_q, c_k, c_v, c_if, c_o, ml_conv_w[i], ml_conv_b[i], ml_b_i[i], ml_b_f[i],
                     ml_norm_g[i]) * jax.nn.silu(c_z)
        g = jax.nn.sigmoid(m_g).reshape(bsz, t_len, N_BRANCH, D_MODEL)
        merged = g[:, :, 0] * (y_a @ w_br_a[i]) + g[:, :, 1] * (y_b @ w_br_b[i]) + g[:, :, 2] * (y_c @ w_br_c[i])
        r = ALPHA * x + merged @ w_out[i]
        r = r + jax.nn.sigmoid(r @ ple_gate[i]) * (p[i] @ ple_w[i])
        x = _layernorm(r, ln_g[i], ln_b[i])
    return x
```

```cpp
#include <hip/hip_runtime.h>
#include <cstdio>
#include <cstdint>

#ifndef MK_PER_PHASE
#define MK_PER_PHASE 0
#endif
#ifndef ABL_A
#define ABL_A 1.0f
#endif
#ifndef ABL_B
#define ABL_B 1.0f
#endif
#ifndef ABL_C
#define ABL_C 1.0f
#endif
constexpr int NB = 8, T = 2048, DM = 1024, M = NB * T, DEPTH = 2, NIN = 8992, PLE = 256;
constexpr float ALPHA = 1.4142135623730951f;
constexpr float LN_EPS = 1e-5f;
constexpr float L2E = 1.4426950408889634f;
constexpr size_t MiB = 1u << 20, KiB = 1u << 10;
constexpr size_t WS_CTL = 0, CTL_ZERO_BYTES = 1 * MiB;
constexpr size_t WS_WIN = 1 * MiB;
constexpr size_t WS_WBR = WS_WIN + 18 * MiB;
constexpr size_t WS_WOUT = WS_WBR + 3 * MiB;
constexpr size_t WS_WPG = WS_WOUT + 2 * MiB;
constexpr size_t WS_WPW = WS_WPG + 2 * MiB;
constexpr size_t WS_CW1 = WS_WPW + 512 * KiB;
constexpr size_t WS_CW2 = WS_CW1 + 1 * MiB;
constexpr size_t WS_SGW = WS_CW2 + 32 * KiB;
constexpr size_t WS_KCMP = WS_SGW + 128 * KiB;
constexpr size_t WS_VCMP = WS_KCMP + 256 * KiB;
constexpr size_t WS_NLOC = WS_VCMP + 256 * KiB;
constexpr size_t WS_MSC = WS_NLOC + 256 * KiB;
constexpr size_t WS_XB = 29 * MiB;
static_assert(WS_MSC + 64 * KiB <= WS_XB, "ws map");
constexpr size_t WS_PB = WS_XB + 32 * MiB;
constexpr size_t WS_NARROW = WS_PB + 8 * MiB;
constexpr size_t WS_CLOC = WS_NARROW + 2 * MiB;
constexpr size_t WS_PROJ = WS_CLOC + 16 * MiB;
constexpr size_t WS_END = WS_PROJ + 184 * MiB;
constexpr size_t F_AZ = 0, F_BU = 16 * MiB, F_BV = 32 * MiB, F_BZ = 48 * MiB, F_CQ = 64 * MiB, F_CK = 80 * MiB,
                 F_CV = 96 * MiB, F_CO = 112 * MiB, F_CZ = 128 * MiB, F_AQ = 144 * MiB, F_KV = 160 * MiB;
constexpr size_t S1 = F_AQ, S2 = F_BV, S3 = F_CQ, S4 = F_CV;
constexpr int CW_BAR = 4096;
constexpr int RING_BYTES = 131072, MISC_OFF = 153600, LDS_BYTES = 154624;
constexpr int NPHASE = 17;
namespace pg8 {
#define PG8_LAS __attribute__((address_space(3)))
typedef unsigned short bf16_t;
typedef short bf16x8 __attribute__((ext_vector_type(8)));
typedef float f32x4 __attribute__((ext_vector_type(4)));
typedef unsigned u32x4 __attribute__((ext_vector_type(4)));
constexpr int BM = 256, BK = 64, HALF = 128, HTB = HALF * BK * 2  , STAGE_BYTES = 8 * HTB, NXCD = 8, WGM = 8;

__host__ __device__ __forceinline__ int lds_byte(int r, int c) { const int st = (r >> 4) * 2 + (c >> 5), rr = r & 15, cc = c & 31, ob = rr * 64 + cc * 2; return st * 1024 + (ob ^ (((ob >> 9) & 1) << 5)); }
__host__ __device__ __forceinline__ void stage_rc(int b, int& R, int& C) { const int st = b / 1024, sb = b % 1024, swz = sb ^ (((sb >> 9) & 1) << 5); R = (st >> 1) * 16 + swz / 64; C = (st & 1) * 32 + (swz % 64) / 2; }
__host__ __device__ __forceinline__ int perm32(int rho) { const int n = rho >> 4, i = rho & 15; return 8 * (i >> 2) + 4 * n + (i & 3); }

struct Unit { int pm, pn; };
struct Gemm { const bf16_t* A; const bf16_t* Bt; int M, N, K; };

struct StaticOrder {
    int nM, nN, nwg, G, c;
    __host__ __device__ void init(int M, int N, int G_, int c_) { nM = M / BM; nN = N / BM; nwg = nM * nN; G = G_; c = c_; }
    __host__ __device__ bool next(int i, Unit& u) const {
        const long L = (long)i * G + c; if (L >= nwg) return false;
        int wgid = (int)L; { const int q = nwg / NXCD, r = nwg % NXCD, xcd = wgid % NXCD, off = wgid / NXCD; wgid = (xcd < r ? xcd * (q + 1) : r * (q + 1) + (xcd - r) * q) + off; }
        const int nig = WGM * nN, gid = wgid / nig, fm = gid * WGM, gsz = (nM - fm) < WGM ? (nM - fm) : WGM;
        u.pm = fm + ((wgid % nig) % gsz); u.pn = (wgid % nig) / gsz; return true;
    }
    __device__ __forceinline__ void a_ready(const Unit&) const {}
    __device__ __forceinline__ void done(const Unit&) const {}
};

__device__ __forceinline__ unsigned cvt_pk_bf16(float lo, float hi) { unsigned r; asm volatile("v_cvt_pk_bf16_f32 %0, %1, %2" : "=v"(r) : "v"(lo), "v"(hi)); return r; }
typedef float f32x2 __attribute__((ext_vector_type(2)));
template <class Epi, class Sched, bool ALIGN_EPI = false, bool SP2 = false>
__device__ __forceinline__ void gemm_phase(PG8_LAS unsigned char* lds, const Gemm g, const Sched& S, const Epi& E) {
    int tid_l = threadIdx.x; asm volatile("" : "+v"(tid_l));
    const int tid = tid_l, wid = __builtin_amdgcn_readfirstlane(tid >> 6), lane = tid & 63, wr = wid >> 2, wc = wid & 3, fr = lane & 15, fq = lane >> 4;
    const int K = g.K, nt = K / BK;
    unsigned voffA[2], voffB[2];
#pragma unroll
    for (int i = 0; i < 2; ++i) { int R, C; stage_rc(tid * 16 + i * 8192, R, C); const int Rb = Epi::PERM ? ((R & ~31) + perm32(R & 31)) : R;
        voffA[i] = (unsigned)(R * K + C) * 2u; voffB[i] = (unsigned)(Rb * K + C) * 2u; }
    const size_t kstep = (size_t)(BK * 2);
    const size_t hstep = (size_t)HALF * K * 2;
    const size_t tstep = 2 * hstep;
    const unsigned ldsw = (unsigned)wid * 1024u;
    const int aoff = lds_byte(wr * 64 + fr, fq * 8), boff = lds_byte(wc * 32 + fr, fq * 8);
#define PG8_SA(b, h) (((b) * 2 + (h)) * HTB)
#define PG8_SB(b, h) ((4 + (b) * 2 + (h)) * HTB)
#define PG8_STAGE(bufoff, gbase, voff) do { _Pragma("unroll") for (int _i = 0; _i < 2; ++_i) \
        __builtin_amdgcn_global_load_lds((const unsigned*)((const char*)(gbase) + (voff)[_i]), (PG8_LAS unsigned*)(lds + (bufoff) + ldsw + _i * 8192), 16, 0, 0); } while (0)
#define PG8_LDA(dst, b, h) do { _Pragma("unroll") for (int m = 0; m < 4; ++m) _Pragma("unroll") for (int k = 0; k < 2; ++k) dst[m][k] = *(const PG8_LAS bf16x8*)(lds + PG8_SA(b, h) + aoff + m * 2048 + k * 1024); } while (0)
#define PG8_LDB(dst, b, h) do { _Pragma("unroll") for (int n = 0; n < 2; ++n) _Pragma("unroll") for (int k = 0; k < 2; ++k) dst[n][k] = *(const PG8_LAS bf16x8*)(lds + PG8_SB(b, h) + boff + n * 2048 + k * 1024); } while (0)
#define PG8_MMA(ai, bj, At, Bt) do { __builtin_amdgcn_s_setprio(1); _Pragma("unroll") for (int m = 0; m < 4; ++m) _Pragma("unroll") for (int n = 0; n < 2; ++n) _Pragma("unroll") for (int k = 0; k < 2; ++k) \
        acc[ai][bj][m][n] = __builtin_amdgcn_mfma_f32_16x16x32_bf16(Bt[n][k], At[m][k], acc[ai][bj][m][n], 0, 0, 0); __builtin_amdgcn_s_setprio(0); } while (0)
#define PG8_WAIT_V(n) asm volatile("s_waitcnt vmcnt(" #n ")" ::: "memory")
#define PG8_WAIT_L(n) asm volatile("s_waitcnt lgkmcnt(" #n ")" ::: "memory")
#define PG8_BAR __builtin_amdgcn_s_barrier()
#define PG8_SCHED __builtin_amdgcn_sched_barrier(0)
    Unit cur, nxt; int ui = 0;
    if (!S.next(0, cur)) return;
    f32x4 acc[2][2][4][2];
#pragma unroll
    for (int a = 0; a < 2; ++a)
#pragma unroll
        for (int b = 0; b < 2; ++b)
#pragma unroll
            for (int m = 0; m < 4; ++m)
#pragma unroll
                for (int n = 0; n < 2; ++n) acc[a][b][m][n] = (f32x4){0.f, 0.f, 0.f, 0.f};
    bf16x8 At[4][2], B0[2][2], B1[2][2];
    const char* cA = (const char*)g.A + (size_t)cur.pm * tstep; const char* cB = (const char*)g.Bt + (size_t)cur.pn * tstep;
    S.a_ready(cur);
    if constexpr (SP2) {
        PG8_STAGE(PG8_SB(0, 0), cB, voffB); PG8_STAGE(PG8_SB(0, 1), cB + hstep, voffB); PG8_STAGE(PG8_SA(0, 0), cA, voffA); PG8_STAGE(PG8_SA(0, 1), cA + hstep, voffA);
        if (wr == 1) PG8_BAR;
        PG8_WAIT_V(2); PG8_BAR;
        PG8_STAGE(PG8_SB(1, 0), cB + kstep, voffB); PG8_STAGE(PG8_SA(1, 0), cA + kstep, voffA); PG8_STAGE(PG8_SB(1, 1), cB + hstep + kstep, voffB);
        PG8_WAIT_V(6); PG8_BAR;
    } else {
        PG8_STAGE(PG8_SB(0, 0), cB, voffB); PG8_STAGE(PG8_SA(0, 0), cA, voffA); PG8_STAGE(PG8_SB(0, 1), cB + hstep, voffB); PG8_STAGE(PG8_SA(0, 1), cA + hstep, voffA);
        if (wr == 1) PG8_BAR;
        PG8_WAIT_V(4); PG8_BAR;
        PG8_STAGE(PG8_SB(1, 0), cB + kstep, voffB); PG8_STAGE(PG8_SA(1, 0), cA + kstep, voffA); PG8_STAGE(PG8_SB(1, 1), cB + hstep + kstep, voffB);
        PG8_WAIT_V(6); PG8_BAR;
    }
    for (;;) {
        const bool has_next = S.next(ui + 1, nxt);
        const char* nA = has_next ? (const char*)g.A + (size_t)nxt.pm * tstep : cA; const char* nB = has_next ? (const char*)g.Bt + (size_t)nxt.pn * tstep : cB;
        for (int t = 0; t < nt; t += 2) {
            const bool last = (t == nt - 2);
            const char* a1 = cA + (size_t)(t + 1) * kstep;
            const char* a2 = last ? nA : cA + (size_t)(t + 2) * kstep; const char* b2 = last ? nB : cB + (size_t)(t + 2) * kstep;
            const char* a3 = a2 + kstep; const char* b3 = b2 + kstep;
            if (last && has_next) S.a_ready(nxt);
            if constexpr (SP2) {
            PG8_LDB(B0, 0, 0); PG8_LDB(B1, 0, 1); PG8_SCHED; PG8_LDA(At, 0, 0); PG8_STAGE(PG8_SA(1, 1), a1 + hstep, voffA);
            PG8_WAIT_V(8); PG8_WAIT_L(0); PG8_BAR; PG8_MMA(0, 0, At, B0); PG8_MMA(0, 1, At, B1); PG8_BAR; PG8_SCHED;
            PG8_LDA(At, 0, 1); PG8_STAGE(PG8_SB(0, 0), b2, voffB); PG8_STAGE(PG8_SB(0, 1), b2 + hstep, voffB); PG8_STAGE(PG8_SA(0, 0), a2, voffA);
            PG8_WAIT_V(8); PG8_WAIT_L(0); PG8_BAR; PG8_MMA(1, 0, At, B0); PG8_MMA(1, 1, At, B1); PG8_BAR; PG8_SCHED;
            PG8_LDB(B0, 1, 0); PG8_LDB(B1, 1, 1); PG8_SCHED; PG8_LDA(At, 1, 0); PG8_STAGE(PG8_SA(0, 1), a2 + hstep, voffA);
            PG8_WAIT_V(8); PG8_WAIT_L(0); PG8_BAR; PG8_MMA(0, 0, At, B0); PG8_MMA(0, 1, At, B1); PG8_BAR; PG8_SCHED;
            PG8_LDA(At, 1, 1); PG8_STAGE(PG8_SB(1, 0), b3, voffB); PG8_STAGE(PG8_SB(1, 1), b3 + hstep, voffB); PG8_STAGE(PG8_SA(1, 0), a3, voffA);
            PG8_WAIT_V(8); PG8_WAIT_L(0); PG8_BAR; PG8_MMA(1, 0, At, B0); PG8_MMA(1, 1, At, B1); PG8_BAR; PG8_SCHED;
            } else {
            PG8_LDB(B0, 0, 0); PG8_SCHED; PG8_LDA(At, 0, 0); PG8_STAGE(PG8_SA(1, 1), a1 + hstep, voffA);
            PG8_WAIT_L(8); PG8_BAR; PG8_WAIT_L(0); PG8_MMA(0, 0, At, B0); PG8_BAR; PG8_SCHED;
            PG8_LDB(B1, 0, 1); PG8_STAGE(PG8_SB(0, 0), b2, voffB);
            PG8_BAR; PG8_WAIT_L(0); PG8_MMA(0, 1, At, B1); PG8_BAR;
            PG8_LDA(At, 0, 1); PG8_STAGE(PG8_SA(0, 0), a2, voffA);
            PG8_BAR; PG8_WAIT_L(0); PG8_MMA(1, 0, At, B0); PG8_BAR; PG8_SCHED;
            PG8_STAGE(PG8_SB(0, 1), b2 + hstep, voffB);
            PG8_WAIT_V(6); PG8_BAR; PG8_MMA(1, 1, At, B1); PG8_BAR;
            PG8_LDB(B0, 1, 0); PG8_SCHED; PG8_LDA(At, 1, 0); PG8_STAGE(PG8_SA(0, 1), a2 + hstep, voffA);
            PG8_WAIT_L(8); PG8_BAR; PG8_WAIT_L(0); PG8_MMA(0, 0, At, B0); PG8_BAR; PG8_SCHED;
            PG8_LDB(B1, 1, 1); PG8_STAGE(PG8_SB(1, 0), b3, voffB);
            PG8_BAR; PG8_WAIT_L(0); PG8_MMA(0, 1, At, B1); PG8_BAR;
            PG8_LDA(At, 1, 1); PG8_STAGE(PG8_SA(1, 0), a3, voffA);
            PG8_BAR; PG8_WAIT_L(0); PG8_MMA(1, 0, At, B0); PG8_BAR; PG8_SCHED;
            PG8_STAGE(PG8_SB(1, 1), b3 + hstep, voffB);
            PG8_WAIT_V(6); PG8_BAR; PG8_MMA(1, 1, At, B1); PG8_BAR;
            }
        }
        if constexpr (ALIGN_EPI) { if (wr == 0) PG8_BAR; }
        if constexpr (!Epi::AFTER_DRAIN) { E(acc, cur, wr, wc, fr, fq); S.done(cur); }
        if (!has_next) break;
#pragma unroll
        for (int a = 0; a < 2; ++a)
#pragma unroll
            for (int b = 0; b < 2; ++b)
#pragma unroll
                for (int m = 0; m < 4; ++m)
#pragma unroll
                    for (int n = 0; n < 2; ++n) acc[a][b][m][n] = (f32x4){0.f, 0.f, 0.f, 0.f};
        cur = nxt; cA = nA; cB = nB; ++ui;
        if constexpr (ALIGN_EPI) { if (wr == 1) PG8_BAR; }
    }
    PG8_WAIT_V(0);
    if constexpr (!ALIGN_EPI) { if (wr == 0) PG8_BAR; }
    PG8_BAR;
    if constexpr (Epi::AFTER_DRAIN) { E.fused(acc, cur, wr, wc, fr, fq, lds, wid, lane); S.done(cur); }
#undef PG8_SA
#undef PG8_SB
#undef PG8_STAGE
#undef PG8_LDA
#undef PG8_LDB
#undef PG8_MMA
#undef PG8_WAIT_V
#undef PG8_WAIT_L
#undef PG8_BAR
#undef PG8_SCHED
}
}
namespace pg8 {
typedef unsigned u32x2 __attribute__((ext_vector_type(2)));
typedef float f32x2v_ __attribute__((ext_vector_type(2))); typedef __bf16 bf16x2v_ __attribute__((ext_vector_type(2)));
__device__ __forceinline__ unsigned cvt2(float lo, float hi) { f32x2v_ v = {lo, hi}; bf16x2v_ b = __builtin_convertvector(v, bf16x2v_); return __builtin_bit_cast(unsigned, b); }
__device__ __forceinline__ float sigmoid_f(float x) { return __builtin_amdgcn_rcpf(1.f + __builtin_amdgcn_exp2f(-1.4426950408889634f * x)); }
__device__ __forceinline__ float silu_f(float x) { return x * sigmoid_f(x); }
__device__ __forceinline__ float gelu_tanh_f(float x) { const float u = 0.7978845608028654f * (x + 0.044715f * x * x * x); return x * sigmoid_f(2.f * u); }
__device__ __forceinline__ float bflo(unsigned w) { return __uint_as_float(w << 16); }
__device__ __forceinline__ float bfhi(unsigned w) { return __uint_as_float(w & 0xffff0000u); }
template <int ACT> __device__ __forceinline__ float act_f(float v) {
    if (ACT == 1) return v * 0.125f; if (ACT == 2) return silu_f(v); if (ACT == 3) return gelu_tanh_f(v); if (ACT == 4) return sigmoid_f(v); return v; }
template <int ACT> __device__ __forceinline__ void store_tile_bf16(const f32x4 (&acc)[2][2][4][2], bf16_t* base, int ld, int row0, int col0) {
#pragma unroll
    for (int ai = 0; ai < 2; ++ai)
#pragma unroll
        for (int m = 0; m < 4; ++m) { bf16_t* rowp = base + (size_t)(row0 + ai * HALF + m * 16) * ld + col0;
#pragma unroll
            for (int bj = 0; bj < 2; ++bj) { const f32x4 v0 = acc[ai][bj][m][0], v1 = acc[ai][bj][m][1]; u32x4 w;
                w.x = cvt2(act_f<ACT>(v0[0]), act_f<ACT>(v0[1])); w.y = cvt2(act_f<ACT>(v0[2]), act_f<ACT>(v0[3]));
                w.z = cvt2(act_f<ACT>(v1[0]), act_f<ACT>(v1[1])); w.w = cvt2(act_f<ACT>(v1[2]), act_f<ACT>(v1[3]));
                *(u32x4*)(rowp + bj * HALF) = w; }
            asm volatile("" ::: "memory"); }
}
struct EpiProj {
    static constexpr bool PERM = true, AFTER_DRAIN = false;
    unsigned char* proj; float* narrow;
    __device__ __forceinline__ void operator()(const f32x4 (&acc)[2][2][4][2], const Unit& u, int wr, int wc, int fr, int fq) const {
        const int row0 = u.pm * BM + wr * 64 + fr; const int pn = u.pn;
        if (pn == 23) {
            if (wc == 0) {
#pragma unroll
                for (int ai = 0; ai < 2; ++ai)
#pragma unroll
                    for (int m = 0; m < 4; ++m) { float* rp = narrow + (size_t)(row0 + ai * HALF + m * 16) * 32 + 8 * fq;
#pragma unroll
                        for (int n = 0; n < 2; ++n) { f32x4 v = acc[ai][0][m][n];
                            if (8 * fq + 4 * n < 24) { v[0] = sigmoid_f(v[0]); v[1] = sigmoid_f(v[1]); v[2] = sigmoid_f(v[2]); v[3] = sigmoid_f(v[3]); }
                            *(f32x4*)(rp + 4 * n) = v; } }
            }
            return;
        }
        size_t fo; int ld, cin, act;
        if (pn < 2) { fo = F_AQ; ld = 512; cin = pn * 256; act = 1; }
        else if (pn < 5) { fo = F_KV; ld = 768; cin = (pn - 2) * 256; act = 0; }
        else { const int f = (pn - 5) >> 1; fo = F_AZ + (size_t)f * (16 * MiB); ld = 512; cin = ((pn - 5) & 1) * 256; act = (int)((0x240002332ull >> (4 * f)) & 0xFull); }
        bf16_t* base = (bf16_t*)(proj + fo); const int col0 = cin + wc * 32 + 8 * fq;
        switch (act) {
            case 0: store_tile_bf16<0>(acc, base, ld, row0, col0); break;
            case 1: store_tile_bf16<1>(acc, base, ld, row0, col0); break;
            case 2: store_tile_bf16<2>(acc, base, ld, row0, col0); break;
            case 3: store_tile_bf16<3>(acc, base, ld, row0, col0); break;
            default: store_tile_bf16<4>(acc, base, ld, row0, col0); break;
        }
    }
};
struct EpiGate {
    static constexpr bool PERM = true, AFTER_DRAIN = false;
    unsigned char* proj;
    __device__ __forceinline__ void operator()(const f32x4 (&acc)[2][2][4][2], const Unit& u, int wr, int wc, int fr, int fq) const {
        const int br = u.pn >> 2; bf16_t* base = (bf16_t*)(proj + (br ? S2 + (size_t)(br - 1) * (S3 - S2) : S1));
        store_tile_bf16<4>(acc, base, 1024, u.pm * BM + wr * 64 + fr, (u.pn & 3) * 256 + wc * 32 + 8 * fq);
    }
};
template <bool FIRST> struct EpiBranch {
    static constexpr bool PERM = true, AFTER_DRAIN = false;
    const bf16_t* G; bf16_t* mg; float scale;
    __device__ __forceinline__ void operator()(const f32x4 (&acc)[2][2][4][2], const Unit& u, int wr, int wc, int fr, int fq) const {
        const int row0 = u.pm * BM + wr * 64 + fr, col0 = u.pn * 256 + wc * 32 + 8 * fq;
#pragma unroll
        for (int ai = 0; ai < 2; ++ai)
#pragma unroll
            for (int m = 0; m < 4; ++m) { const size_t ro = (size_t)(row0 + ai * HALF + m * 16) * 1024 + col0;
#pragma unroll
                for (int bj = 0; bj < 2; ++bj) { const f32x4 v0 = acc[ai][bj][m][0], v1 = acc[ai][bj][m][1];
                    const u32x4 g = *(const u32x4*)(G + ro + bj * HALF);
                    float o[8] = { v0[0] * bflo(g.x), v0[1] * bfhi(g.x), v0[2] * bflo(g.y), v0[3] * bfhi(g.y), v1[0] * bflo(g.z), v1[1] * bfhi(g.z), v1[2] * bflo(g.w), v1[3] * bfhi(g.w) };
#pragma unroll
                    for (int j = 0; j < 8; ++j) o[j] *= scale;
                    if (!FIRST) { const u32x4 p = *(const u32x4*)(mg + ro + bj * HALF);
                        o[0] += bflo(p.x); o[1] += bfhi(p.x); o[2] += bflo(p.y); o[3] += bfhi(p.y); o[4] += bflo(p.z); o[5] += bfhi(p.z); o[6] += bflo(p.w); o[7] += bfhi(p.w); }
                    u32x4 w; w.x = cvt2(o[0], o[1]); w.y = cvt2(o[2], o[3]); w.z = cvt2(o[4], o[5]); w.w = cvt2(o[6], o[7]);
                    *(u32x4*)(mg + ro + bj * HALF) = w; }
                asm volatile("" ::: "memory"); }
    }
};
struct EpiOut {
    static constexpr bool PERM = false, AFTER_DRAIN = false;
    const float* xres; float* out; bf16_t* xb; float alpha;
    __device__ __forceinline__ void operator()(const f32x4 (&acc)[2][2][4][2], const Unit& u, int wr, int wc, int fr, int fq) const {
        const int row0 = u.pm * BM + wr * 64 + fr, col0 = u.pn * 256 + wc * 32 + 4 * fq;
#pragma unroll
        for (int ai = 0; ai < 2; ++ai)
#pragma unroll
            for (int m = 0; m < 4; ++m) { const size_t ro = (size_t)(row0 + ai * HALF + m * 16) * 1024 + col0;
#pragma unroll
                for (int bj = 0; bj < 2; ++bj)
#pragma unroll
                    for (int n = 0; n < 2; ++n) { const size_t o = ro + bj * HALF + n * 16; const f32x4 xi = *(const f32x4*)(xres + o);
                        const f32x4 r = xi * alpha + acc[ai][bj][m][n]; *(f32x4*)(out + o) = r;
                        u32x2 w; w.x = cvt2(r[0], r[1]); w.y = cvt2(r[2], r[3]); *(u32x2*)(xb + o) = w; }
                asm volatile("" ::: "memory"); }
    }
};
struct EpiPw {
    static constexpr bool PERM = true, AFTER_DRAIN = false;
    bf16_t* pw;
    __device__ __forceinline__ void operator()(const f32x4 (&acc)[2][2][4][2], const Unit& u, int wr, int wc, int fr, int fq) const {
        store_tile_bf16<0>(acc, pw, 1024, u.pm * BM + wr * 64 + fr, u.pn * 256 + wc * 32 + 8 * fq);
    }
};
struct EpiPle {
    static constexpr bool PERM = false, AFTER_DRAIN = false;
    float* out; const bf16_t* pw;
    __device__ __forceinline__ void operator()(const f32x4 (&acc)[2][2][4][2], const Unit& u, int wr, int wc, int fr, int fq) const {
        const int row0 = u.pm * BM + wr * 64 + fr, col0 = u.pn * 256 + wc * 32 + 4 * fq;
#pragma unroll
        for (int ai = 0; ai < 2; ++ai)
#pragma unroll
            for (int m = 0; m < 4; ++m) { const size_t ro = (size_t)(row0 + ai * HALF + m * 16) * 1024 + col0;
#pragma unroll
                for (int bj = 0; bj < 2; ++bj)
#pragma unroll
                    for (int n = 0; n < 2; ++n) { const size_t o = ro + bj * HALF + n * 16; f32x4 r = *(const f32x4*)(out + o); const u32x2 p = *(const u32x2*)(pw + o);
                        const f32x4 a = acc[ai][bj][m][n];
                        r[0] += sigmoid_f(a[0]) * bflo(p.x); r[1] += sigmoid_f(a[1]) * bfhi(p.x); r[2] += sigmoid_f(a[2]) * bflo(p.y); r[3] += sigmoid_f(a[3]) * bfhi(p.y);
                        *(f32x4*)(out + o) = r; }
                asm volatile("" ::: "memory"); }
    }
};
}
#define GAS __attribute__((address_space(1)))
#define LAS __attribute__((address_space(3)))
typedef unsigned short bf16;
typedef unsigned v4u __attribute__((ext_vector_type(4)));
typedef float f32x4 __attribute__((ext_vector_type(4)));
typedef short bf16x8 __attribute__((ext_vector_type(8)));
typedef GAS unsigned gu32;
typedef GAS unsigned long long gu64;
#define RLX_AGENT __ATOMIC_RELAXED, __HIP_MEMORY_SCOPE_AGENT
#define LDS_WAIT() asm volatile("s_waitcnt lgkmcnt(0)" ::: "memory")
#define VM_WAIT() asm volatile("s_waitcnt vmcnt(0)" ::: "memory")
__device__ __forceinline__ unsigned long long rt() { return __builtin_amdgcn_s_memrealtime(); }
__device__ __forceinline__ unsigned f2bf(float f) { unsigned u = __builtin_bit_cast(unsigned, f); return (u + 0x7fffu + ((u >> 16) & 1u)) >> 16; }
__device__ __forceinline__ unsigned pk2(float lo, float hi) { return f2bf(lo) | (f2bf(hi) << 16); }
#define XB_TMO      128
#define XB_XCNT(j)  (256  + 64 * (j))
#define XB_XSUB(j)  (1280 + 64 * (j))
#define XB_XGEN(j)  (2304 + 64 * (j))
#define XB_TOP      3328
#define XB_TOPGEN   3392
#define XCD_BAR_WORDS 3456
#define XB_SPIN_CAP (1u << 18)

__device__ __forceinline__ unsigned xb_ld(unsigned* p)              { return __hip_atomic_load(p, __ATOMIC_RELAXED, __HIP_MEMORY_SCOPE_AGENT); }
__device__ __forceinline__ unsigned xb_add(unsigned* p, unsigned v) { return __hip_atomic_fetch_add(p, v, __ATOMIC_RELAXED, __HIP_MEMORY_SCOPE_AGENT); }
__device__ __forceinline__ unsigned xb_xcc_id() { return (unsigned)__builtin_amdgcn_s_getreg((3 << 11) | 20) & 0xFu; }
#define XB_SPIN(cond, bar) do { unsigned _sp = 0; while (cond) { __builtin_amdgcn_s_sleep(1); \
    if ((++_sp & 255u) == 0u) { if (xb_ld(&(bar)[XB_TMO])) break; if (_sp > XB_SPIN_CAP) { atomicAdd(&(bar)[XB_TMO], 1u); break; } } } } while (0)

struct XcdBarrier {
    unsigned* bar; unsigned x;
    volatile LAS unsigned* st;
};

__device__ __forceinline__ XcdBarrier xcd_barrier_post(unsigned* bar, volatile LAS unsigned* st) {
    XcdBarrier b; b.bar = bar; b.x = xb_xcc_id(); b.st = st;
    if (threadIdx.x == 0) (void)xb_add(&bar[XB_XCNT(b.x)], 1u);
    return b;
}
__device__ __forceinline__ void xcd_barrier_complete(unsigned* bar, unsigned x, unsigned& nloc, unsigned& nx) {
    const unsigned G = gridDim.x * gridDim.y * gridDim.z;
    unsigned sum, cnt, mine, sp = 0u;
    for (;;) {
        sum = 0u; cnt = 0u; mine = 0u;
#pragma unroll
        for (unsigned j = 0; j < 16; ++j) { const unsigned c = xb_ld(&bar[XB_XCNT(j)]); sum += c; cnt += (c > 0u) ? 1u : 0u; mine = (j == x) ? c : mine; }
        if (sum == G) break;
        __builtin_amdgcn_s_sleep(1);
        if ((++sp & 255u) == 0u) { if (xb_ld(&bar[XB_TMO])) break; if (sp > XB_SPIN_CAP) { atomicAdd(&bar[XB_TMO], 1u); break; } }
    }
    nloc = mine > 0u ? mine : 1u; nx = cnt > 0u ? cnt : 1u;
}

__device__ __forceinline__ void xcd_barrier(const XcdBarrier& b) {
    asm volatile("s_waitcnt vmcnt(0)" ::: "memory");
    __syncthreads();
    if (threadIdx.x == 0) {
        unsigned* bar = b.bar;
        __builtin_amdgcn_s_waitcnt(0);
        unsigned nloc = b.st[0], nx = b.st[1];
        if (nloc == 0u) { xcd_barrier_complete(bar, b.x, nloc, nx); b.st[0] = nloc; b.st[1] = nx; }
        const unsigned old = xb_add(&bar[XB_XSUB(b.x)], 1u);
        const unsigned gen = old / nloc;
        if (old + 1u == (gen + 1u) * nloc) {
            __builtin_amdgcn_fence(__ATOMIC_RELEASE, "agent");
            asm volatile("s_waitcnt vmcnt(0)" ::: "memory");
            const unsigned og = xb_add(&bar[XB_TOP], 1u);
            const unsigned tg = og / nx;
            if (og + 1u == (tg + 1u) * nx) xb_add(&bar[XB_TOPGEN], 1u);
            else XB_SPIN(xb_ld(&bar[XB_TOPGEN]) == tg, bar);
            __builtin_amdgcn_fence(__ATOMIC_ACQUIRE, "agent");
            xb_add(&bar[XB_XGEN(b.x)], 1u);
            asm volatile("s_waitcnt vmcnt(0)" ::: "memory");
        } else {
            XB_SPIN(xb_ld(&bar[XB_XGEN(b.x)]) == gen, bar);
            __builtin_amdgcn_fence(__ATOMIC_ACQUIRE, "agent");
            asm volatile("s_waitcnt vmcnt(0)" ::: "memory");
        }
    }
    __syncthreads();
}
typedef short v4i16_t __attribute__((ext_vector_type(4)));
typedef unsigned u32x2 __attribute__((ext_vector_type(2)));
typedef float f32x2_t __attribute__((ext_vector_type(2)));
typedef __bf16 bf16x2_t __attribute__((ext_vector_type(2)));
typedef LAS unsigned char* lds_t;
__device__ __forceinline__ unsigned cvtpk(float lo, float hi) { f32x2_t v = {lo, hi}; bf16x2_t b = __builtin_convertvector(v, bf16x2_t); return __builtin_bit_cast(unsigned, b); }
__device__ __forceinline__ float bflo(unsigned w) { return __uint_as_float(w << 16); }
__device__ __forceinline__ float bfhi(unsigned w) { return __uint_as_float(w & 0xffff0000u); }
__device__ __forceinline__ void unpack8(const v4u w, float (&f)[8]) { f[0] = bflo(w.x); f[1] = bfhi(w.x); f[2] = bflo(w.y); f[3] = bfhi(w.y); f[4] = bflo(w.z); f[5] = bfhi(w.z); f[6] = bflo(w.w); f[7] = bfhi(w.w); }
__device__ __forceinline__ v4u pack8(const float (&f)[8]) { v4u w; w.x = cvtpk(f[0], f[1]); w.y = cvtpk(f[2], f[3]); w.z = cvtpk(f[4], f[5]); w.w = cvtpk(f[6], f[7]); return w; }
__device__ __forceinline__ float sigm(float x) { return __builtin_amdgcn_rcpf(1.f + __builtin_amdgcn_exp2f(-L2E * x)); }
__device__ __forceinline__ float siluf(float x) { return x * sigm(x); }
__device__ __forceinline__ float gelut(float x) { const float u = 0.7978845608028654f * (x + 0.044715f * x * x * x); return x * sigm(2.f * u); }
__device__ __forceinline__ f32x4 mfma16(bf16x8 a, bf16x8 b, f32x4 c) { return __builtin_amdgcn_mfma_f32_16x16x32_bf16(a, b, c, 0, 0, 0); }
__device__ __forceinline__ v4i16_t trd(lds_t p) { return __builtin_amdgcn_ds_read_tr16_b64_v4i16((LAS v4i16_t*)p); }
__device__ __forceinline__ bf16x8 tr_pair(lds_t base, int stride, int rowb, int col, int fr, int Q) {
    lds_t p = base + (rowb + 4 * Q + (fr >> 2)) * stride + (col + 4 * (fr & 3)) * 2;
    const v4i16_t a = trd(p), b = trd(p + 16 * stride);
    return (bf16x8){a[0], a[1], a[2], a[3], b[0], b[1], b[2], b[3]};
}
__device__ __forceinline__ bf16x8 mk_frag(u32x2 a, u32x2 b) { v4u w; w.x = a.x; w.y = a.y; w.z = b.x; w.w = b.y; return __builtin_bit_cast(bf16x8, w); }
__device__ __forceinline__ float logsigf(float x) { return fminf(x, 0.f) - log1pf(expf(-fabsf(x))); }
__device__ __forceinline__ const float* ld_ptr(const LAS unsigned long long* t, int k) {
    const unsigned long long v = t[k];
    const unsigned lo = __builtin_amdgcn_readfirstlane((unsigned)v), hi = __builtin_amdgcn_readfirstlane((unsigned)(v >> 32));
    return (const float*)(const GAS float*)(uintptr_t)(((unsigned long long)hi << 32) | lo);
}
__device__ __forceinline__ float wave_sum(float v) {
#pragma unroll
    for (int o = 1; o < 64; o <<= 1) v += __shfl_xor(v, o);
    return v;
}
__device__ __forceinline__ void tr_item(const float* W, int ldw, bf16* WT, int K, int row_off, LAS float* scr, int kb, int nb, int lane) {
    const int k0 = 64 * kb, n0 = 32 * nb;
#pragma unroll 8
    for (int i = 0; i < 32; ++i) { const int kk = 2 * i + (lane >> 5); scr[kk * 33 + (lane & 31)] = W[(size_t)(k0 + kk) * ldw + n0 + (lane & 31)]; }
    LDS_WAIT(); asm volatile("" ::: "memory");
    const int c = lane & 7;
#pragma unroll
    for (int j = 0; j < 4; ++j) { const int n = (lane >> 3) + 8 * j; const LAS float* s = scr + (8 * c) * 33 + n;
        v4u o; o.x = cvtpk(s[0 * 33], s[1 * 33]); o.y = cvtpk(s[2 * 33], s[3 * 33]); o.z = cvtpk(s[4 * 33], s[5 * 33]); o.w = cvtpk(s[6 * 33], s[7 * 33]);
        *(v4u*)(WT + (size_t)(row_off + n0 + n) * K + k0 + 8 * c) = o; }
    LDS_WAIT(); asm volatile("" ::: "memory");
}
__device__ __forceinline__ void cvt_rows(const float* src, bf16* dst, size_t n8, size_t gt, size_t ngt) {
    for (size_t i = gt; i < n8; i += ngt) { const f32x4 a = *(const f32x4*)(src + 8 * i), b = *(const f32x4*)(src + 8 * i + 4);
        v4u o; o.x = cvtpk(a[0], a[1]); o.y = cvtpk(a[2], a[3]); o.z = cvtpk(b[0], b[1]); o.w = cvtpk(b[2], b[3]); *(v4u*)(dst + 8 * i) = o; }
}
__device__ __forceinline__ void conv_layer(const LAS unsigned long long* ptab, unsigned char* ws, int L, lds_t lds, int vcu, int G, int tid, int lane, int wave) {
    LAS float* scr = (LAS float*)(lds + wave * 16384);
    const int gw = vcu * 8 + wave, NGW = G * 8;
    const float* w_in = ld_ptr(ptab, 2) + (size_t)L * 1024 * NIN;
    bf16* WIN = (bf16*)(ws + WS_WIN); bf16* WBR = (bf16*)(ws + WS_WBR);
    constexpr int I0 = 16 * 40, I1 = 16 * 112, I2 = 16 * 32, I3 = 16 * 96, IBR = 8 * 32, IO = 16 * 32, IPW = 4 * 32, IC1 = 32 * 4, IC2 = 2 * 2;
    constexpr int NITEMS = I0 + I1 + I2 + I3 + 3 * IBR + 2 * IO + IPW + 2 * IC1 + 2 * IC2;
#define TR_JOB(Wp, ldw, K, ncols, WTp, roff) { constexpr int ni_ = ((K) / 64) * ((ncols) / 32); if (r < ni_) { tr_item((Wp), (ldw), (WTp), (K), (roff), scr, r / ((ncols) / 32), r % ((ncols) / 32), lane); continue; } r -= ni_; }
    for (int it = gw; it < NITEMS; it += NGW) {
        int r = it;
        TR_JOB(w_in + 0, NIN, 1024, 1280, WIN, 0)
        TR_JOB(w_in + 1304, NIN, 1024, 3584, WIN, 1280)
        TR_JOB(w_in + 4896, NIN, 1024, 1024, WIN, 4864)
        TR_JOB(w_in + 5920, NIN, 1024, 3072, WIN, 6144)
        TR_JOB(ld_ptr(ptab, 18) + (size_t)L * 512 * 1024, 1024, 512, 1024, WBR, 0)
        TR_JOB(ld_ptr(ptab, 19) + (size_t)L * 512 * 1024, 1024, 512, 1024, WBR + 1024 * 512, 0)
        TR_JOB(ld_ptr(ptab, 20) + (size_t)L * 512 * 1024, 1024, 512, 1024, WBR + 2 * 1024 * 512, 0)
        TR_JOB(ld_ptr(ptab, 21) + (size_t)L * 1024 * 1024, 1024, 1024, 1024, (bf16*)(ws + WS_WOUT), 0)
        TR_JOB(ld_ptr(ptab, 23) + (size_t)L * 1024 * 1024, 1024, 1024, 1024, (bf16*)(ws + WS_WPG), 0)
        TR_JOB(ld_ptr(ptab, 22) + (size_t)L * 256 * 1024, 1024, 256, 1024, (bf16*)(ws + WS_WPW), 0)
        TR_JOB(ld_ptr(ptab, 5) + (size_t)L * 2048 * 128, 128, 2048, 128, (bf16*)(ws + WS_CW1), 0)
        TR_JOB(ld_ptr(ptab, 7) + (size_t)L * 2048 * 128, 128, 2048, 128, (bf16*)(ws + WS_CW1) + 128 * 2048, 0)
        TR_JOB(ld_ptr(ptab, 6) + (size_t)L * 128 * 64, 64, 128, 64, (bf16*)(ws + WS_CW2), 0)
        TR_JOB(ld_ptr(ptab, 8) + (size_t)L * 128 * 64, 64, 128, 64, (bf16*)(ws + WS_CW2) + 64 * 128, 0)
    }
#undef TR_JOB
    const size_t gt = (size_t)vcu * 512 + tid, ngt = (size_t)G * 512;
    for (size_t i = gt; i < (size_t)256 * 1024; i += ngt) { const int rr = (int)(i >> 10), k = (int)(i & 1023);
        float v = 0.f; if (rr < 24) v = w_in[(size_t)k * NIN + 1280 + rr]; else if (rr < 32) v = w_in[(size_t)k * NIN + 4888 + (rr - 24)];
        WIN[(size_t)(5888 + rr) * 1024 + k] = (bf16)(cvtpk(v, 0.f) & 0xffffu); }
    { const float* sgw = ld_ptr(ptab, 11) + (size_t)L * 4 * 128 * 128; bf16* o = (bf16*)(ws + WS_SGW);
      for (size_t i = gt; i < (size_t)4 * 128 * 128; i += ngt) { const int s = (int)(i & 127), t = (int)((i >> 7) & 127); const float v = (s <= t) ? sgw[i] : 0.f; o[i] = (bf16)(cvtpk(v, 0.f) & 0xffffu); } }
    cvt_rows(ld_ptr(ptab, 1) + (size_t)L * M * PLE, (bf16*)(ws + WS_PB), (size_t)M * PLE / 8, gt, ngt);
}
__device__ __forceinline__ void ln_row(const float* xrow, float* orow, bf16* brow, const float* g, const float* bta, int lane) {
    const f32x4* xr = (const f32x4*)xrow + lane;
    f32x4 v[4]; float s = 0.f;
#pragma unroll
    for (int j = 0; j < 4; ++j) { v[j] = xr[64 * j]; s += (v[j][0] + v[j][1]) + (v[j][2] + v[j][3]); }
    const float mean = wave_sum(s) * (1.f / 1024.f); float s2 = 0.f;
#pragma unroll
    for (int j = 0; j < 4; ++j) { v[j] = v[j] - mean; s2 += (v[j][0] * v[j][0] + v[j][1] * v[j][1]) + (v[j][2] * v[j][2] + v[j][3] * v[j][3]); }
    const float rstd = 1.f / sqrtf(wave_sum(s2) * (1.f / 1024.f) + LN_EPS);
#pragma unroll
    for (int j = 0; j < 4; ++j) { const f32x4 gg = *((const f32x4*)g + lane + 64 * j), bb = *((const f32x4*)bta + lane + 64 * j);
        const f32x4 o = v[j] * rstd * gg + bb; *((f32x4*)orow + lane + 64 * j) = o;
        u32x2 w; w.x = cvtpk(o[0], o[1]); w.y = cvtpk(o[2], o[3]); *((u32x2*)brow + lane + 64 * j) = w; }
}
constexpr int TS = 288;
constexpr int TILE_B = 128 * TS;

__device__ __forceinline__ void gmlp_item(lds_t lds, int item, bf16* BU, const bf16* BV, const bf16* BZ, const float* lng, const float* lnb, const bf16* sgw, const float* sgb,
                                          int tid, int lane, int wave) {
    const int g = item & 3, c = (item >> 2) & 15, b = item >> 6;
    const size_t tok0 = (size_t)b * T + c * 128;
    LAS float* stats = (LAS float*)(lds + 40960);
    {
        const int s = tid >> 2, part = tid & 3; const bf16* p = BV + (tok0 + s) * 512 + part * 128; float sum = 0.f, sq = 0.f;
#pragma unroll
        for (int i = 0; i < 16; ++i) { const v4u w = *(const v4u*)(p + 8 * i); float f[8]; unpack8(w, f);
#pragma unroll
            for (int j = 0; j < 8; ++j) { sum += f[j]; sq += f[j] * f[j]; } }
        sum += __shfl_xor(sum, 1); sum += __shfl_xor(sum, 2); sq += __shfl_xor(sq, 1); sq += __shfl_xor(sq, 2);
        const float mean = sum * (1.f / 512.f), var = fmaxf(sq * (1.f / 512.f) - mean * mean, 0.f);
        if (part == 0) { stats[2 * s] = mean; stats[2 * s + 1] = 1.f / sqrtf(var + LN_EPS); }
    }
    __syncthreads();
#pragma unroll
    for (int i = 0; i < 4; ++i) {
        const int idx = tid + 512 * i, s = idx >> 4, ch = idx & 15; const int col = g * 128 + 8 * ch;
        const v4u w = *(const v4u*)(BV + (tok0 + s) * 512 + col); float f[8]; unpack8(w, f);
        const float mean = stats[2 * s], rstd = stats[2 * s + 1];
        const f32x4 g0 = *(const f32x4*)(lng + col), g1 = *(const f32x4*)(lng + col + 4), b0 = *(const f32x4*)(lnb + col), b1 = *(const f32x4*)(lnb + col + 4);
#pragma unroll
        for (int j = 0; j < 4; ++j) { f[j] = (f[j] - mean) * rstd * g0[j] + b0[j]; f[4 + j] = (f[4 + j] - mean) * rstd * g1[j] + b1[j]; }
        *(LAS v4u*)(lds + s * TS + ch * 16) = pack8(f);
    }
    __syncthreads();
    const int fr = lane & 15, Q = lane >> 4, tl = 16 * wave + fr;
    f32x4 acc[8];
#pragma unroll
    for (int n = 0; n < 8; ++n) acc[n] = (f32x4){0.f, 0.f, 0.f, 0.f};
    const bf16* wrow = sgw + (size_t)(g * 128 + tl) * 128;
    const int nk = (wave >> 1) + 1;
    for (int kk = 0; kk < nk; ++kk) {
        const u32x2 b0 = *(const u32x2*)(wrow + 32 * kk + 4 * Q), b1 = *(const u32x2*)(wrow + 32 * kk + 16 + 4 * Q);
        const bf16x8 bfr = mk_frag(b0, b1);
#pragma unroll
        for (int n = 0; n < 8; ++n) acc[n] = mfma16(tr_pair(lds, TS, 32 * kk, 16 * n, fr, Q), bfr, acc[n]);
    }
    const float bias = sgb[g * 128 + tl]; const size_t tok = tok0 + tl;
#pragma unroll
    for (int n = 0; n < 8; ++n) { const size_t off = tok * 512 + g * 128 + 16 * n + 4 * Q;
        const u32x2 u = *(const u32x2*)(BU + off), z = *(const u32x2*)(BZ + off);
        u32x2 w; w.x = cvtpk(bflo(u.x) * (acc[n][0] + bias) * bflo(z.x), bfhi(u.x) * (acc[n][1] + bias) * bfhi(z.x));
        w.y = cvtpk(bflo(u.y) * (acc[n][2] + bias) * bflo(z.y), bfhi(u.y) * (acc[n][3] + bias) * bfhi(z.y));
        *(u32x2*)(BU + off) = w; }
    __syncthreads();
}

__device__ __forceinline__ void mlstm_gates(LAS float* garr, const float* narrow, size_t tok0, int h, float bi, float bfo, int lane) {
    const float* p0 = narrow + (tok0 + 2 * lane) * 32;
    const float li0 = p0[24 + h] + bi, li1 = p0[32 + 24 + h] + bi;
    const float lf0 = logsigf(p0[28 + h] + bfo), lf1 = logsigf(p0[32 + 28 + h] + bfo);
    const float c1 = lf0 + lf1; float run = c1;
#pragma unroll
    for (int o = 1; o < 64; o <<= 1) { const float t = __shfl_up(run, o); if (lane >= o) run += t; }
    const float ex = run - c1, bc0 = ex + lf0, bc1 = ex + c1;
    const float a0 = li0 - bc0, a1 = li1 - bc1; const float m1 = fmaxf(a0, a1); float rm = m1;
#pragma unroll
    for (int o = 1; o < 64; o <<= 1) { const float t = __shfl_up(rm, o); if (lane >= o) rm = fmaxf(rm, t); }
    float pe = __shfl_up(rm, 1); if (lane == 0) pe = -INFINITY;
    garr[2 * lane] = bc0; garr[2 * lane + 1] = bc1; garr[128 + 2 * lane] = a0; garr[128 + 2 * lane + 1] = a1;
    garr[256 + 2 * lane] = fmaxf(pe, a0); garr[256 + 2 * lane + 1] = rm;
}
__device__ __forceinline__ void stage_conv(lds_t dst, const bf16* src, size_t tok0, int tin0, int h, const float* cw, const float* cb, float scale, int tid) {
    const int ch = tid & 15, col = h * 128 + 8 * ch;
    float w[4][8], bb[8];
#pragma unroll
    for (int wi = 0; wi < 4; ++wi) { const f32x4 x0 = *(const f32x4*)(cw + wi * 1024 + col), x1 = *(const f32x4*)(cw + wi * 1024 + col + 4);
#pragma unroll
        for (int j = 0; j < 4; ++j) { w[wi][j] = x0[j]; w[wi][4 + j] = x1[j]; } }
    { const f32x4 x0 = *(const f32x4*)(cb + col), x1 = *(const f32x4*)(cb + col + 4);
#pragma unroll
      for (int j = 0; j < 4; ++j) { bb[j] = x0[j]; bb[4 + j] = x1[j]; } }
#pragma unroll
    for (int i = 0; i < 4; ++i) { const int s = (tid >> 4) + 32 * i; float a[8];
#pragma unroll
        for (int j = 0; j < 8; ++j) a[j] = bb[j];
#pragma unroll
        for (int wi = 0; wi < 4; ++wi) { const int ts = s - 3 + wi;
            if (tin0 + ts >= 0) { const v4u x = *(const v4u*)(src + (size_t)((long)tok0 + ts) * 512 + col); float f[8]; unpack8(x, f);
#pragma unroll
                for (int j = 0; j < 8; ++j) a[j] += w[wi][j] * f[j]; } }
#pragma unroll
        for (int j = 0; j < 8; ++j) a[j] = siluf(a[j]) * scale;
        *(LAS v4u*)(dst + s * TS + ch * 16) = pack8(a); }
}

__device__ __forceinline__ void mlstm1_item(lds_t lds, int item, const bf16* CK, const bf16* CV, const float* narrow, const float* cw, const float* cb, const float* b_i, const float* b_f,
                                            bf16* cloc, float* nloc, float* msc, int tid, int lane, int wave) {
    const int c = item & 15, h = (item >> 4) & 3, b = item >> 6;
    const size_t tok0 = (size_t)b * T + c * 128;
    lds_t Ks = lds, Vs = lds + TILE_B; LAS float* garr = (LAS float*)(lds + 2 * TILE_B); LAS float* red = garr + 384;
    if (wave == 0) mlstm_gates(garr, narrow, tok0, h, b_i[h], b_f[h], lane);
    stage_conv(Ks, CK, tok0, c * 128, h, cw + 512, cb + 512, 0.08838834764831845f, tid);
    __syncthreads();
    const float pm = garr[256 + 127], bl = garr[127];
#pragma unroll
    for (int i = 0; i < 4; ++i) { const int idx = tid + 512 * i, s = idx >> 4, ch = idx & 15;
        const float e = expf(garr[128 + s] - pm);
        const v4u x = *(const v4u*)(CV + (tok0 + s) * 512 + h * 128 + 8 * ch); float f[8]; unpack8(x, f);
#pragma unroll
        for (int j = 0; j < 8; ++j) f[j] *= e;
        *(LAS v4u*)(Vs + s * TS + ch * 16) = pack8(f); }
    {
        const int k = tid & 127, part = tid >> 7; float sacc = 0.f;
        for (int s = 32 * part; s < 32 * part + 32; ++s) { const float e = expf(garr[128 + s] - pm); const unsigned short kv = *(const LAS unsigned short*)(Ks + s * TS + k * 2); sacc += e * __uint_as_float((unsigned)kv << 16); }
        red[part * 128 + k] = sacc;
    }
    __syncthreads();
    const int fr = lane & 15, Q = lane >> 4;
    f32x4 acc[8];
#pragma unroll
    for (int n = 0; n < 8; ++n) acc[n] = (f32x4){0.f, 0.f, 0.f, 0.f};
#pragma unroll
    for (int kk = 0; kk < 4; ++kk) { const bf16x8 bfr = tr_pair(Vs, TS, 32 * kk, 16 * wave, fr, Q);
#pragma unroll
        for (int kt = 0; kt < 8; ++kt) acc[kt] = mfma16(tr_pair(Ks, TS, 32 * kk, 16 * kt, fr, Q), bfr, acc[kt]); }
    { const int v = 16 * wave + fr; bf16* dst = cloc + ((size_t)item * 128 + v) * 128;
#pragma unroll
      for (int kt = 0; kt < 8; ++kt) { u32x2 w; w.x = cvtpk(acc[kt][0], acc[kt][1]); w.y = cvtpk(acc[kt][2], acc[kt][3]); *(u32x2*)(dst + 16 * kt + 4 * Q) = w; } }
    if (tid < 128) nloc[(size_t)item * 128 + tid] = (red[tid] + red[128 + tid]) + (red[256 + tid] + red[384 + tid]);
    if (tid == 0) { msc[2 * item] = bl + pm; msc[2 * item + 1] = bl; }
    __syncthreads();
}

__device__ __forceinline__ void mlstm3_item(lds_t lds, int item, const bf16* CQ, const bf16* CK, const bf16* CV, const bf16* CO, bf16* CZ, const float* narrow, const float* cw, const float* cb,
                                            const float* b_i, const float* b_f, const float* norm_g, const bf16* cloc, const float* nloc, const float* msc, int tid, int lane, int wave) {
    const int c = item & 15, h = (item >> 4) & 3, b = item >> 6, bh = item >> 4;
    const size_t tok0 = (size_t)b * T + c * 128;
    lds_t Qs = lds, Ks = lds + TILE_B, Vs = lds + 2 * TILE_B, Cp = lds + 3 * TILE_B; LAS float* garr = (LAS float*)(lds + 4 * TILE_B); LAS float* npv = garr + 384;
    float mp = 0.f;
    for (int j = 0; j < c; ++j) { const float ml = msc[2 * (bh * 16 + j)], blj = msc[2 * (bh * 16 + j) + 1]; mp = fmaxf(blj + mp, ml); }
    if (wave == 0) mlstm_gates(garr, narrow, tok0, h, b_i[h], b_f[h], lane);
    stage_conv(Qs, CQ, tok0, c * 128, h, cw, cb, 1.0f, tid);
    stage_conv(Ks, CK, tok0, c * 128, h, cw + 512, cb + 512, 0.08838834764831845f, tid);
#pragma unroll
    for (int i = 0; i < 4; ++i) { const int idx = tid + 512 * i, s = idx >> 4, ch = idx & 15;
        *(LAS v4u*)(Vs + s * TS + ch * 16) = *(const v4u*)(CV + (tok0 + s) * 512 + h * 128 + 8 * ch); }
    float zf = 0.f; asm volatile("" : "+v"(zf));
#pragma unroll
    for (int i = 0; i < 4; ++i) { const int idx = tid + 512 * i, v = idx >> 4, ch = idx & 15; float a[8];
#pragma unroll
        for (int j = 0; j < 8; ++j) a[j] = zf;
        float S = 0.f;
        for (int j = c - 1; j >= 0; --j) { const float ml = msc[2 * (bh * 16 + j)], blj = msc[2 * (bh * 16 + j) + 1]; const float w = expf(S + ml - mp);
            const v4u x = *(const v4u*)(cloc + ((size_t)(bh * 16 + j) * 128 + v) * 128 + 8 * ch); float f[8]; unpack8(x, f);
#pragma unroll
            for (int q = 0; q < 8; ++q) a[q] += w * f[q];
            S += blj; }
        *(LAS v4u*)(Cp + v * TS + ch * 16) = pack8(a); }
    if (tid < 128) { float a = 0.f, S = 0.f;
        for (int j = c - 1; j >= 0; --j) { const float ml = msc[2 * (bh * 16 + j)], blj = msc[2 * (bh * 16 + j) + 1]; a += expf(S + ml - mp) * nloc[(size_t)(bh * 16 + j) * 128 + tid]; S += blj; }
        npv[tid] = a; }
    __syncthreads();
    const int fr = lane & 15, Q = lane >> 4, t = 16 * wave + fr;
    const float Mt = fmaxf(mp, garr[256 + t]), eint = expf(mp - Mt), emt = expf(-garr[t] - Mt);
    bf16x8 qf[4];
#pragma unroll
    for (int kk = 0; kk < 4; ++kk) qf[kk] = *(const LAS bf16x8*)(Qs + t * TS + (32 * kk + 8 * Q) * 2);
    unsigned pk[8][2]; float den = 0.f;
#pragma unroll
    for (int st = 0; st < 8; ++st) {
        if (st <= wave) {
            f32x4 sa = (f32x4){0.f, 0.f, 0.f, 0.f};
#pragma unroll
            for (int kk = 0; kk < 4; ++kk) sa = mfma16(*(const LAS bf16x8*)(Ks + (16 * st + fr) * TS + (32 * kk + 8 * Q) * 2), qf[kk], sa);
            float p[4];
#pragma unroll
            for (int r = 0; r < 4; ++r) { const int s = 16 * st + 4 * Q + r; p[r] = (s <= t) ? sa[r] * expf(garr[128 + s] - Mt) : 0.f; den += p[r]; }
            pk[st][0] = cvtpk(p[0], p[1]); pk[st][1] = cvtpk(p[2], p[3]);
        } else { pk[st][0] = 0u; pk[st][1] = 0u; }
    }
    f32x4 a1[8], a2[8];
#pragma unroll
    for (int n = 0; n < 8; ++n) { a1[n] = (f32x4){0.f, 0.f, 0.f, 0.f}; a2[n] = (f32x4){0.f, 0.f, 0.f, 0.f}; }
#pragma unroll
    for (int kk = 0; kk < 4; ++kk) {
        if (2 * kk <= wave) { v4u w; w.x = pk[2 * kk][0]; w.y = pk[2 * kk][1]; w.z = pk[2 * kk + 1][0]; w.w = pk[2 * kk + 1][1]; const bf16x8 bfr = __builtin_bit_cast(bf16x8, w);
#pragma unroll
            for (int vt = 0; vt < 8; ++vt) a1[vt] = mfma16(tr_pair(Vs, TS, 32 * kk, 16 * vt, fr, Q), bfr, a1[vt]); }
    }
    float dint = 0.f;
#pragma unroll
    for (int kk = 0; kk < 4; ++kk) {
#pragma unroll
        for (int vt = 0; vt < 8; ++vt) a2[vt] = mfma16(*(const LAS bf16x8*)(Cp + (16 * vt + fr) * TS + (32 * kk + 8 * Q) * 2), qf[kk], a2[vt]);
        float f[8]; unpack8(__builtin_bit_cast(v4u, qf[kk]), f);
#pragma unroll
        for (int j = 0; j < 8; ++j) dint += npv[32 * kk + 8 * Q + j] * f[j];
    }
    den += __shfl_xor(den, 16); den += __shfl_xor(den, 32); dint += __shfl_xor(dint, 16); dint += __shfl_xor(dint, 32);
    const float dtot = den + eint * dint; const float rden = 1.f / fmaxf(fabsf(dtot), emt);
    float sum = 0.f;
#pragma unroll
    for (int vt = 0; vt < 8; ++vt)
#pragma unroll
        for (int r = 0; r < 4; ++r) { a1[vt][r] = (a1[vt][r] + eint * a2[vt][r]) * rden; sum += a1[vt][r]; }
    sum += __shfl_xor(sum, 16); sum += __shfl_xor(sum, 32);
    const float mu = sum * (1.f / 128.f); float sq = 0.f;
#pragma unroll
    for (int vt = 0; vt < 8; ++vt)
#pragma unroll
        for (int r = 0; r < 4; ++r) { const float d = a1[vt][r] - mu; sq += d * d; }
    sq += __shfl_xor(sq, 16); sq += __shfl_xor(sq, 32);
    const float rstd = 1.f / sqrtf(sq * (1.f / 128.f) + LN_EPS);
    const size_t tok = tok0 + t;
#pragma unroll
    for (int vt = 0; vt < 8; ++vt) { const int col = h * 128 + 16 * vt + 4 * Q; const size_t off = tok * 512 + col;
        const f32x4 ng = *(const f32x4*)(norm_g + col); const u32x2 o = *(const u32x2*)(CO + off), z = *(const u32x2*)(CZ + off);
        u32x2 w; w.x = cvtpk((a1[vt][0] - mu) * rstd * ng[0] * bflo(o.x) * bflo(z.x), (a1[vt][1] - mu) * rstd * ng[1] * bfhi(o.x) * bfhi(z.x));
        w.y = cvtpk((a1[vt][2] - mu) * rstd * ng[2] * bflo(o.y) * bflo(z.y), (a1[vt][3] - mu) * rstd * ng[3] * bfhi(o.y) * bfhi(z.y));
        *(u32x2*)(CZ + off) = w; }
    __syncthreads();
}
__device__ __forceinline__ void cmp_item(lds_t lds, int item, const bf16* KV, const float* posk, const float* posv, const bf16* w1t, const bf16* w2t, bf16* kcmp, bf16* vcmp,
                                         int tid, int lane, int wave) {
    const int nt = item & 7, kv = (item >> 3) & 1, g = (item >> 4) & 1, b = item >> 5;
    const int fr = lane & 15, Q = lane >> 4;
    const float* pos = kv ? posv : posk; const bf16* W1 = w1t + (size_t)kv * 128 * 2048; const bf16* W2 = w2t + (size_t)kv * 64 * 128;
    bf16* outp = (kv ? vcmp : kcmp) + (size_t)((b * 2 + g) * 128) * 64;
    const int n = 16 * nt + fr;
    const bf16* arow = KV + (size_t)b * T * 768 + kv * 128 + g * 64;
    const bf16* brow = W1 + (size_t)(16 * wave + fr) * 2048;
    f32x4 acc = (f32x4){0.f, 0.f, 0.f, 0.f};
#pragma unroll 4
    for (int ks = 0; ks < 64; ++ks) { const int l = ks >> 1, d0 = 32 * (ks & 1) + 8 * Q;
        int tk = 16 * n + l; tk = tk > T - 1 ? T - 1 : tk;
        const v4u x = *(const v4u*)(arow + (size_t)tk * 768 + d0); float f[8]; unpack8(x, f);
        const f32x4 p0 = *(const f32x4*)(pos + l * 64 + d0), p1 = *(const f32x4*)(pos + l * 64 + d0 + 4);
#pragma unroll
        for (int j = 0; j < 4; ++j) { f[j] += p0[j]; f[4 + j] += p1[j]; }
        const bf16x8 afr = __builtin_bit_cast(bf16x8, pack8(f));
        const bf16x8 bfr = *(const bf16x8*)(brow + 32 * ks + 8 * Q);
        acc = mfma16(afr, bfr, acc); }
#pragma unroll
    for (int r = 0; r < 4; ++r) { const unsigned hv = cvtpk(gelut(acc[r]), 0.f); *(LAS unsigned short*)(lds + (4 * Q + r) * 272 + (16 * wave + fr) * 2) = (unsigned short)(hv & 0xffffu); }
    __syncthreads();
    if (wave < 4) {
        f32x4 o = (f32x4){0.f, 0.f, 0.f, 0.f};
#pragma unroll
        for (int kk = 0; kk < 4; ++kk) { const bf16x8 afr = *(const LAS bf16x8*)(lds + fr * 272 + (32 * kk + 8 * Q) * 2);
            const bf16x8 bfr = *(const bf16x8*)(W2 + (size_t)(16 * wave + fr) * 128 + 32 * kk + 8 * Q);
            o = mfma16(afr, bfr, o); }
#pragma unroll
        for (int r = 0; r < 4; ++r) { const int nn = 16 * nt + 4 * Q + r; const float v = (nn < 127) ? o[r] : 0.f;
            outp[(size_t)nn * 64 + 16 * wave + fr] = (bf16)(cvtpk(v, 0.f) & 0xffffu); }
    }
    __syncthreads();
}

constexpr int VS = 160;
constexpr int NSA_WAVE_LDS = 64 * VS;
struct NsaCtx { int fr, Q, tq, t0, cur; unsigned selmask; lds_t wl; };
__device__ __forceinline__ void nsa_scores(f32x4 (&st)[4], const bf16x8 (&kf)[4][2], const bf16x8 (&q)[2]) {
#pragma unroll
    for (int kt = 0; kt < 4; ++kt) { st[kt] = mfma16(kf[kt][0], q[0], (f32x4){0.f, 0.f, 0.f, 0.f}); st[kt] = mfma16(kf[kt][1], q[1], st[kt]); }
}
template <int MODE> __device__ __forceinline__ bool nsa_valid(const NsaCtx& c, int key, int& dist) {
    if (MODE == 0) { dist = c.tq - (16 * key + 31); return dist >= 0; }
    dist = c.tq - key;
    if (MODE == 1) return dist >= 0;
    return dist >= 0 && dist < 256;
}
template <int MODE, int NHH> __device__ __forceinline__ void nsa_pass1(const NsaCtx& c, const bf16* Kb, int ld, int j_lo, int j_hi, const bf16x8 (&qf)[NHH][2], const float (&slope2)[NHH],
                                                                       float (&mrun)[NHH], float (&inv)[NHH]) {
    const int fr = c.fr, Q = c.Q;
    float lrun[NHH];
#pragma unroll
    for (int h = 0; h < NHH; ++h) { mrun[h] = -1e30f; lrun[h] = 0.f; }
#pragma unroll 1
    for (int j = j_lo; j <= j_hi; ++j) {
        if (MODE == 1) { if (!__any((int)((c.selmask >> j) & 1u))) continue; }
        const bool blk_ok = (MODE != 1) || ((c.selmask >> j) & 1u);
        const int key0 = 64 * j;
        bf16x8 kf[4][2];
#pragma unroll
        for (int kt = 0; kt < 4; ++kt)
#pragma unroll
            for (int ks = 0; ks < 2; ++ks) kf[kt][ks] = *(const bf16x8*)(Kb + (size_t)(key0 + 16 * kt + fr) * ld + 32 * ks + 8 * Q);
#pragma unroll
        for (int h = 0; h < NHH; ++h) { f32x4 st[4]; nsa_scores(st, kf, qf[h]);
            float sc[16]; float mx = -1e30f;
#pragma unroll
            for (int kt = 0; kt < 4; ++kt)
#pragma unroll
                for (int r = 0; r < 4; ++r) { int dist; const bool ok = nsa_valid<MODE>(c, key0 + 16 * kt + 4 * Q + r, dist) && blk_ok;
                    const float v = ok ? (st[kt][r] * L2E - slope2[h] * (float)dist) : -1e30f; sc[4 * kt + r] = v; mx = fmaxf(mx, v); }
            const float mn = fmaxf(mrun[h], mx); float s = 0.f;
#pragma unroll
            for (int i = 0; i < 16; ++i) s += (sc[i] > -1e29f) ? __builtin_amdgcn_exp2f(sc[i] - mn) : 0.f;
            lrun[h] = lrun[h] * __builtin_amdgcn_exp2f(mrun[h] - mn) + s; mrun[h] = mn; }
    }
#pragma unroll
    for (int h = 0; h < NHH; ++h) { float mt = fmaxf(mrun[h], __shfl_xor(mrun[h], 16)); mt = fmaxf(mt, __shfl_xor(mt, 32));
        float l = lrun[h] * __builtin_amdgcn_exp2f(mrun[h] - mt); l += __shfl_xor(l, 16); l += __shfl_xor(l, 32);
        mrun[h] = mt; inv[h] = 1.f / fmaxf(l, 1e-30f); }
}
template <int MODE, int NHH, bool IMP, bool PV> __device__ __forceinline__ void nsa_pass2(const NsaCtx& c, const bf16* Kb, const bf16* Vb, int ld, int j_lo, int j_hi, const bf16x8 (&qf)[NHH][2],
        const float (&slope2)[NHH], const float (&mrun)[NHH], const float (&inv)[NHH], const float (&gate)[NHH], f32x4 (&oacc)[NHH][4], float (&imp)[8], int lane) {
    const int fr = c.fr, Q = c.Q;
#pragma unroll 1
    for (int j = j_lo; j <= j_hi; ++j) {
        if (MODE == 1) { if (!__any((int)((c.selmask >> j) & 1u))) continue; }
        const bool blk_ok = (MODE != 1) || ((c.selmask >> j) & 1u);
        const int key0 = 64 * j;
        bf16x8 kf[4][2];
#pragma unroll
        for (int kt = 0; kt < 4; ++kt)
#pragma unroll
            for (int ks = 0; ks < 2; ++ks) kf[kt][ks] = *(const bf16x8*)(Kb + (size_t)(key0 + 16 * kt + fr) * ld + 32 * ks + 8 * Q);
        if (PV) {
            asm volatile("" ::: "memory");
#pragma unroll
            for (int i = 0; i < 8; ++i) { const int row = (lane >> 3) + 8 * i, cc = lane & 7;
                *(LAS v4u*)(c.wl + row * VS + cc * 16) = *(const v4u*)(Vb + (size_t)(key0 + row) * ld + 8 * cc); }
            asm volatile("s_waitcnt lgkmcnt(0)" ::: "memory");
        }
#pragma unroll
        for (int h = 0; h < NHH; ++h) { f32x4 st[4]; nsa_scores(st, kf, qf[h]);
            unsigned pk[4][2]; const float cf = inv[h] * gate[h];
#pragma unroll
            for (int kt = 0; kt < 4; ++kt) { float p[4];
#pragma unroll
                for (int r = 0; r < 4; ++r) { int dist; const bool ok = nsa_valid<MODE>(c, key0 + 16 * kt + 4 * Q + r, dist) && blk_ok;
                    p[r] = ok ? __builtin_amdgcn_exp2f(st[kt][r] * L2E - slope2[h] * (float)dist - mrun[h]) : 0.f; }
                if (IMP) {
                    const int Tt = 4 * j + kt; const float pn3 = p[3] * inv[h]; const float own = ((p[0] + p[1]) + (p[2] + p[3])) * inv[h];
                    const float recv = __shfl(pn3, (lane + 48) & 63);
#pragma unroll
                    for (int tt = 0; tt < 8; ++tt) { if (tt == Tt) imp[tt] += own + (Q > 0 ? recv : 0.f); if (tt == Tt + 1) imp[tt] += (Q == 0 ? recv : 0.f); }
                }
                if (PV) { pk[kt][0] = cvtpk(p[0] * cf, p[1] * cf); pk[kt][1] = cvtpk(p[2] * cf, p[3] * cf); } }
            if (PV) {
#pragma unroll
                for (int kk = 0; kk < 2; ++kk) { v4u w; w.x = pk[2 * kk][0]; w.y = pk[2 * kk][1]; w.z = pk[2 * kk + 1][0]; w.w = pk[2 * kk + 1][1]; const bf16x8 bfr = __builtin_bit_cast(bf16x8, w);
#pragma unroll
                    for (int dt = 0; dt < 4; ++dt) oacc[h][dt] = mfma16(tr_pair(c.wl, VS, 32 * kk, 16 * dt, fr, Q), bfr, oacc[h][dt]); }
            }
        }
        if (PV) asm volatile("s_waitcnt lgkmcnt(0)" ::: "memory");
    }
}
__device__ __forceinline__ void nsa_unit(lds_t wl, int b, int g, int qt, const bf16* AQ, const bf16* KV, bf16* AZ, const float* narrow, const bf16* kcmp, const bf16* vcmp, int lane) {
    NsaCtx c; c.fr = lane & 15; c.Q = lane >> 4; c.t0 = 16 * qt; c.tq = c.t0 + c.fr; c.cur = c.t0 >> 6; c.selmask = 0u; c.wl = wl;
    const size_t tokq = (size_t)b * T + c.tq;
    const bf16* kvb = KV + (size_t)b * T * 768 + g * 64;
    const bf16* kcb = kcmp + (size_t)((b * 2 + g) * 128) * 64; const bf16* vcb = vcmp + (size_t)((b * 2 + g) * 128) * 64;
    const int cmp_hi = (c.t0 >= 16) ? (((c.t0 - 16) >> 4) >> 6) : -1;
    const float* gp = narrow + tokq * 32 + g * 4;
    float imp[8];
#pragma unroll
    for (int i = 0; i < 8; ++i) imp[i] = 0.f;
    if (c.cur <= 7) c.selmask = (2u << c.cur) - 1u;
    else {
#pragma unroll 1
        for (int hp = 0; hp < 2; ++hp) {
            const int h0 = 2 * hp;
            bf16x8 qf[2][2]; float slope2[2], mrun[2], inv[2], gate[2]; f32x4 odummy[2][4];
#pragma unroll
            for (int h = 0; h < 2; ++h) { slope2[h] = ldexpf(L2E, -(g * 4 + h0 + h + 1)); gate[h] = 0.f;
#pragma unroll
                for (int ks = 0; ks < 2; ++ks) qf[h][ks] = *(const bf16x8*)(AQ + tokq * 512 + g * 256 + (h0 + h) * 64 + 32 * ks + 8 * c.Q); }
            nsa_pass1<0, 2>(c, kcb, 64, 0, cmp_hi, qf, slope2, mrun, inv);
            nsa_pass2<0, 2, true, false>(c, kcb, vcb, 64, 0, cmp_hi, qf, slope2, mrun, inv, gate, odummy, imp, lane);
        }
        unsigned sel = 1u | (1u << c.cur) | (1u << (c.cur - 1));
        float cand[8];
#pragma unroll
        for (int tt = 0; tt < 8; ++tt) { const int jb = 4 * tt + c.Q; cand[tt] = (jb > 0 && jb < c.cur - 1) ? imp[tt] : -1.f; }
#pragma unroll 1
        for (int it = 0; it < 5; ++it) {
            float bv = cand[0]; int bj = c.Q;
#pragma unroll
            for (int tt = 1; tt < 8; ++tt) if (cand[tt] > bv) { bv = cand[tt]; bj = 4 * tt + c.Q; }
#pragma unroll
            for (int off = 16; off <= 32; off <<= 1) { const float ov = __shfl_xor(bv, off); const int oj = __shfl_xor(bj, off); if (ov > bv || (ov == bv && oj < bj)) { bv = ov; bj = oj; } }
            sel |= 1u << bj;
#pragma unroll
            for (int tt = 0; tt < 8; ++tt) if (4 * tt + c.Q == bj) cand[tt] = -1.f;
        }
        c.selmask = sel;
    }
#pragma unroll 1
    for (int hp = 0; hp < 2; ++hp) {
        const int h0 = 2 * hp;
        bf16x8 qf[2][2]; float slope2[2], mrun[2], inv[2], gate[2]; f32x4 oacc[2][4];
#pragma unroll
        for (int h = 0; h < 2; ++h) { slope2[h] = ldexpf(L2E, -(g * 4 + h0 + h + 1));
#pragma unroll
            for (int ks = 0; ks < 2; ++ks) qf[h][ks] = *(const bf16x8*)(AQ + tokq * 512 + g * 256 + (h0 + h) * 64 + 32 * ks + 8 * c.Q);
#pragma unroll
            for (int dt = 0; dt < 4; ++dt) oacc[h][dt] = (f32x4){0.f, 0.f, 0.f, 0.f}; }
        if (cmp_hi >= 0) {
            gate[0] = gp[h0]; gate[1] = gp[h0 + 1];
            nsa_pass1<0, 2>(c, kcb, 64, 0, cmp_hi, qf, slope2, mrun, inv);
            nsa_pass2<0, 2, false, true>(c, kcb, vcb, 64, 0, cmp_hi, qf, slope2, mrun, inv, gate, oacc, imp, lane);
        }
        gate[0] = gp[8 + h0]; gate[1] = gp[8 + h0 + 1];
        nsa_pass1<1, 2>(c, kvb + 256, 768, 0, c.cur, qf, slope2, mrun, inv);
        nsa_pass2<1, 2, false, true>(c, kvb + 256, kvb + 384, 768, 0, c.cur, qf, slope2, mrun, inv, gate, oacc, imp, lane);
        gate[0] = gp[16 + h0]; gate[1] = gp[16 + h0 + 1];
        { const int lo = c.t0 - 255, jl = (lo > 0 ? lo : 0) >> 6;
          nsa_pass1<2, 2>(c, kvb + 512, 768, jl, c.cur, qf, slope2, mrun, inv);
          nsa_pass2<2, 2, false, true>(c, kvb + 512, kvb + 640, 768, jl, c.cur, qf, slope2, mrun, inv, gate, oacc, imp, lane); }
#pragma unroll
        for (int h = 0; h < 2; ++h)
#pragma unroll
            for (int dt = 0; dt < 4; ++dt) { const size_t off = tokq * 512 + g * 256 + (h0 + h) * 64 + 16 * dt + 4 * c.Q; const u32x2 z = *(const u32x2*)(AZ + off);
                u32x2 w; w.x = cvtpk(oacc[h][dt][0] * bflo(z.x), oacc[h][dt][1] * bfhi(z.x)); w.y = cvtpk(oacc[h][dt][2] * bflo(z.y), oacc[h][dt][3] * bfhi(z.y));
                *(u32x2*)(AZ + off) = w; }
    }
}
#ifndef PHSEL
#define PHSEL -1
#endif
#define PHEN(k) (PHSEL < 0 || PHSEL == (k))
#ifndef DBG_SKIP_GMLP
#define DBG_SKIP_GMLP 0
#endif
#ifndef DBG_SKIPMASK
#define DBG_SKIPMASK 0
#endif
#ifndef DBG_NPH
#define DBG_NPH NPHASE
#endif
#define INP(k) ld_ptr(ptab, (k))
struct OneUnit { pg8::Unit u;
    __device__ __forceinline__ bool next(int i, pg8::Unit& o) const { if (i != 0) return false; o = u; return true; }
    __device__ __forceinline__ void a_ready(const pg8::Unit&) const {}
    __device__ __forceinline__ void done(const pg8::Unit&) const {} };
struct Args { const float* in[26]; float* out; unsigned char* ws; int ph_lo, ph_hi; };
static_assert(sizeof(Args) == 26 * 8 + 8 + 8 + 8, "Args has no padding");

__global__ void __launch_bounds__(512, 2) mk_fwd(Args args) {
    extern __shared__ __attribute__((aligned(16))) unsigned char lds_raw[];
    lds_t lds = (lds_t)lds_raw;
    const int tid0 = threadIdx.x;
    const int G0_ = gridDim.x; const int bx0_ = blockIdx.x;
    volatile LAS unsigned* MISC = (volatile LAS unsigned*)(lds + MISC_OFF);
    if (tid0 < 32) MISC[tid0] = 0u;
    LAS unsigned long long* ptab = (LAS unsigned long long*)(lds + MISC_OFF + 256);
    if (tid0 == 0) {
#pragma unroll
        for (int i = 0; i < 26; ++i) ptab[i] = (unsigned long long)(uintptr_t)args.in[i];
    }
    __syncthreads();
    unsigned char* ws0 = args.ws; float* out = args.out;
    gu32* ctl = (gu32*)(ws0 + WS_CTL);
    XcdBarrier bar; bar.bar = (unsigned*)(ctl + CW_BAR); bar.x = 0; bar.st = nullptr;
#if !MK_PER_PHASE
    bar = xcd_barrier_post((unsigned*)(ctl + CW_BAR), MISC + 8);
#endif
    for (int ph = args.ph_lo; ph < args.ph_hi; ++ph) {
        const int L = ph == 0 ? 0 : (ph - 1) >> 3, sub = ph == 0 ? -1 : (ph - 1) & 7;
        int tid = tid0; asm volatile("" : "+v"(tid));
        const int lane = tid & 63, wave = __builtin_amdgcn_readfirstlane(tid >> 6);
        int G = G0_, bx = bx0_; asm volatile("" : "+s"(G), "+s"(bx));
        const int vcu = (G % 8 == 0) ? (bx % 8) * (G / 8) + bx / 8 : bx;
        GAS unsigned char* wsg = (GAS unsigned char*)ws0; asm volatile("" : "+s"(wsg)); unsigned char* ws = (unsigned char*)wsg;
        unsigned char* proj = ws + WS_PROJ;
        bf16* XB = (bf16*)(ws + WS_XB); bf16* PBb = (bf16*)(ws + WS_PB); float* narrow = (float*)(ws + WS_NARROW);
        bf16* WIN = (bf16*)(ws + WS_WIN);
        bf16* AQ = (bf16*)(proj + F_AQ); bf16* KV = (bf16*)(proj + F_KV); bf16* AZ = (bf16*)(proj + F_AZ); bf16* BU = (bf16*)(proj + F_BU); bf16* BV = (bf16*)(proj + F_BV);
        bf16* BZ = (bf16*)(proj + F_BZ); bf16* CQ = (bf16*)(proj + F_CQ); bf16* CK = (bf16*)(proj + F_CK); bf16* CV = (bf16*)(proj + F_CV); bf16* CO = (bf16*)(proj + F_CO);
        bf16* CZ = (bf16*)(proj + F_CZ);
        bf16* G0 = (bf16*)(proj + S1); bf16* G1 = (bf16*)(proj + S2); bf16* G2 = (bf16*)(proj + S3); bf16* MG = (bf16*)(proj + S4); bf16* PW = (bf16*)(proj + S1);
        bf16* kcmp = (bf16*)(ws + WS_KCMP); bf16* vcmp = (bf16*)(ws + WS_VCMP); bf16* cloc = (bf16*)(ws + WS_CLOC); float* nloc = (float*)(ws + WS_NLOC); float* msc = (float*)(ws + WS_MSC);

        if (ph >= NPHASE || ((DBG_SKIPMASK >> ph) & 1)) {
        } else if (ph == 0 && PHEN(0)) {
            cvt_rows(INP(0), XB, (size_t)M * DM / 8, (size_t)vcu * 512 + tid, (size_t)G * 512);
        } else if (sub == 0 && PHEN(1)) {
            pg8::Gemm g{XB, WIN, M, 6144, 1024}; pg8::StaticOrder S; S.init(M, 6144, G, bx);
            pg8::EpiProj E{proj, narrow};
#pragma unroll 1
            for (int i = 0;; ++i) { OneUnit O; if (!S.next(i, O.u)) break; pg8::gemm_phase<pg8::EpiProj, OneUnit, false, true>(lds, g, O, E); }
        } else if (sub == 1 && PHEN(2)) {
            const float* cw = INP(13) + (size_t)L * 4 * 1024; const float* cb = INP(14) + (size_t)L * 1024;
            for (int it = bx; it < 256 + 512 + 512; it += G) {
                if (it < 256) cmp_item(lds, it, KV, INP(3) + (size_t)L * 32 * 64, INP(4) + (size_t)L * 32 * 64, (const bf16*)(ws + WS_CW1), (const bf16*)(ws + WS_CW2), kcmp, vcmp, tid, lane, wave);
                else if (it < 768) mlstm1_item(lds, it - 256, CK, CV, narrow, cw, cb, INP(15) + L * 4, INP(16) + L * 4, cloc, nloc, msc, tid, lane, wave);
                else if (!DBG_SKIP_GMLP) gmlp_item(lds, it - 768, BU, BV, BZ, INP(9) + (size_t)L * 512, INP(10) + (size_t)L * 512, (const bf16*)(ws + WS_SGW), INP(12) + (size_t)L * 512, tid, lane, wave);
            }
        } else if (sub == 2 && PHEN(3)) {
            const float* cw = INP(13) + (size_t)L * 4 * 1024; const float* cb = INP(14) + (size_t)L * 1024;
#ifndef DBG_NO_ML3
            for (int it = bx; it < 512; it += G)
                mlstm3_item(lds, it, CQ, CK, CV, CO, CZ, narrow, cw, cb, INP(15) + L * 4, INP(16) + L * 4, INP(17) + (size_t)L * 512, cloc, nloc, msc, tid, lane, wave);
#endif
            __syncthreads();
#ifndef DBG_NO_NSA
            for (int k = 0;; ++k) { const int rho = bx + G * (wave + 8 * k); if (rho >= 2048) break;
                const int qt = 127 - (rho >> 4), bg = rho & 15;
                int lane_u = lane; asm volatile("" : "+v"(lane_u));
                nsa_unit(lds + wave * NSA_WAVE_LDS, bg >> 1, bg & 1, qt, AQ, KV, AZ, narrow, kcmp, vcmp, lane_u); }
#endif
        } else if (sub == 3 && PHEN(4)) {
            pg8::Gemm g{XB, WIN + (size_t)6144 * 1024, M, 3072, 1024}; pg8::StaticOrder S; S.init(M, 3072, G, bx);
            pg8::EpiGate E{proj};
#pragma unroll 1
            for (int i = 0;; ++i) { OneUnit O; if (!S.next(i, O.u)) break; pg8::gemm_phase<pg8::EpiGate, OneUnit, false, true>(lds, g, O, E); }
        } else if (sub == 4 && PHEN(5)) {
            bf16* WBR = (bf16*)(ws + WS_WBR); pg8::StaticOrder S; S.init(M, 1024, G, bx);
            { pg8::Gemm g{AZ, WBR, M, 1024, 512}; pg8::EpiBranch<true> E{G0, MG, ABL_A}; pg8::gemm_phase<pg8::EpiBranch<true>, pg8::StaticOrder, false, true>(lds, g, S, E); }
            { pg8::Gemm g{BU, WBR + 1024 * 512, M, 1024, 512}; pg8::EpiBranch<false> E{G1, MG, ABL_B}; pg8::gemm_phase<pg8::EpiBranch<false>, pg8::StaticOrder, false, true>(lds, g, S, E); }
            { pg8::Gemm g{CZ, WBR + 2 * 1024 * 512, M, 1024, 512}; pg8::EpiBranch<false> E{G2, MG, ABL_C}; pg8::gemm_phase<pg8::EpiBranch<false>, pg8::StaticOrder, false, true>(lds, g, S, E); }
        } else if (sub == 5 && PHEN(6)) {
            pg8::StaticOrder S; S.init(M, 1024, G, bx);
            { pg8::Gemm g{MG, (const bf16*)(ws + WS_WOUT), M, 1024, 1024}; pg8::EpiOut E{L == 0 ? INP(0) : (const float*)out, out, XB, ALPHA};
              pg8::gemm_phase<pg8::EpiOut, pg8::StaticOrder, false, true>(lds, g, S, E); }
            { pg8::Gemm g{PBb, (const bf16*)(ws + WS_WPW), M, 1024, 256}; pg8::EpiPw E{PW}; pg8::gemm_phase<pg8::EpiPw, pg8::StaticOrder, false, true>(lds, g, S, E); }
        } else if (sub == 6 && PHEN(7)) {
            pg8::StaticOrder S; S.init(M, 1024, G, bx);
            pg8::Gemm g{XB, (const bf16*)(ws + WS_WPG), M, 1024, 1024}; pg8::EpiPle E{out, PW};
            pg8::gemm_phase<pg8::EpiPle, pg8::StaticOrder, false, true>(lds, g, S, E);
        } else if (PHEN(8)) {
            const float* lg = INP(24) + (size_t)L * 1024; const float* lb = INP(25) + (size_t)L * 1024;
            for (int m = vcu * 8 + wave; m < M; m += G * 8) ln_row(out + (size_t)m * DM, out + (size_t)m * DM, XB + (size_t)m * DM, lg, lb, lane);
        }
        if ((ph == 0 || ph == 8) && PHEN(0)) {
            int Lv = ph == 0 ? 0 : 1; asm volatile("" : "+v"(Lv)); const int Lc = __builtin_amdgcn_readfirstlane(Lv);
            conv_layer(ptab, ws, Lc, lds, vcu, G, tid, lane, wave);
        }
#ifdef DBG_DUMP_OFF
        if (ph == 100) {
            const bf16* src = (const bf16*)(ws + DBG_DUMP_OFF);
            for (size_t i = (size_t)bx * 512 + tid; i < (size_t)M * DM; i += (size_t)G * 512) out[i] = __uint_as_float((unsigned)src[i] << 16);
        }
#endif
#if !MK_PER_PHASE
        if (ph + 1 < args.ph_hi) { XcdBarrier b2 = bar; asm volatile("" : "+s"(b2.bar), "+s"(b2.x)); xcd_barrier(b2); }
#endif
    }
}

__global__ void fill_const(float* out, int n, float v) { for (int i = blockIdx.x * blockDim.x + threadIdx.x; i < n; i += gridDim.x * blockDim.x) out[i] = v; }

extern "C" void kernel_launch(void* const* d_in, const int* in_sizes, int n_in, void* d_out, int out_size, void* d_ws, size_t ws_size, hipStream_t stream) {
    static int grid = 0;
    if (grid == 0) {
        int dev = 0, cus = 0, per_cu = 0;
        if (n_in != 26 || out_size != M * DM || ws_size < WS_END) { fprintf(stderr, "kernel_launch: unexpected shapes (n_in %d out %d ws %zu, need %zu)\n", n_in, out_size, ws_size, (size_t)WS_END); grid = -1; }
        else if (hipGetDevice(&dev) != hipSuccess || hipDeviceGetAttribute(&cus, hipDeviceAttributeMultiprocessorCount, dev) != hipSuccess) grid = -1;
        else if (hipFuncSetAttribute((const void*)mk_fwd, hipFuncAttributeMaxDynamicSharedMemorySize, LDS_BYTES) != hipSuccess) grid = -1;
        else {
            if (hipOccupancyMaxActiveBlocksPerMultiprocessor(&per_cu, (const void*)mk_fwd, 512, LDS_BYTES) != hipSuccess || per_cu < 1) { fprintf(stderr, "kernel_launch: occupancy query says %d blocks per CU\n", per_cu); per_cu = 0; }
            (void)hipGetLastError();
            grid = per_cu >= 1 ? cus : -1;
        }
    }
    if (grid < 0) {
        hipLaunchKernelGGL(fill_const, dim3(1024), dim3(256), 0, stream, (float*)d_out, out_size, (float)((double)ws_size / 1.0e8));
        return;
    }
    (void)hipMemsetAsync((char*)d_ws + WS_CTL, 0, CTL_ZERO_BYTES, stream);
    Args a{};
    for (int i = 0; i < 26; ++i) a.in[i] = (const float*)d_in[i];
    a.out = (float*)d_out; a.ws = (unsigned char*)d_ws;
#if MK_PER_PHASE
    for (int ph = 0; ph < DBG_NPH; ++ph) { a.ph_lo = ph; a.ph_hi = ph + 1; hipLaunchKernelGGL(mk_fwd, dim3(grid), dim3(512), LDS_BYTES, stream, a); }
#ifdef DBG_DUMP_OFF
    a.ph_lo = 100; a.ph_hi = 101; hipLaunchKernelGGL(mk_fwd, dim3(grid), dim3(512), LDS_BYTES, stream, a);
#endif
#else
    a.ph_lo = 0; a.ph_hi = NPHASE;
    void* kargs[] = {&a};
    const hipError_t e = hipLaunchCooperativeKernel((const void*)mk_fwd, dim3(grid), dim3(512), kargs, LDS_BYTES, stream);
    if (e != hipSuccess) fprintf(stderr, "kernel_launch: cooperative launch failed: %s (grid %d)\n", hipGetErrorString(e), grid);
#endif
}
```

```cpp
#include <hip/hip_runtime.h>
#include <cstdio>
#include <cstdint>

#ifndef MK_PER_PHASE
#define MK_PER_PHASE 0
#endif
#ifndef ABL_A
#define ABL_A 1.0f
#endif
#ifndef ABL_B
#define ABL_B 1.0f
#endif
#ifndef ABL_C
#define ABL_C 1.0f
#endif
constexpr int NB = 8, T = 2048, DM = 1024, M = NB * T, DEPTH = 2, NIN = 8992, PLE = 256;
constexpr float ALPHA = 1.4142135623730951f;
constexpr float LN_EPS = 1e-5f;
constexpr float L2E = 1.4426950408889634f;
constexpr size_t MiB = 1u << 20, KiB = 1u << 10;
constexpr size_t WS_CTL = 0, CTL_ZERO_BYTES = 1 * MiB;
constexpr size_t WS_WIN = 1 * MiB;
constexpr size_t WS_WBR = WS_WIN + 18 * MiB;
constexpr size_t WS_WOUT = WS_WBR + 3 * MiB;
constexpr size_t WS_WPG = WS_WOUT + 2 * MiB;
constexpr size_t WS_WPW = WS_WPG + 2 * MiB;
constexpr size_t WS_CW1 = WS_WPW + 512 * KiB;
constexpr size_t WS_CW2 = WS_CW1 + 1 * MiB;
constexpr size_t WS_SGW = WS_CW2 + 32 * KiB;
constexpr size_t WS_KCMP = WS_SGW + 128 * KiB;
constexpr size_t WS_VCMP = WS_KCMP + 256 * KiB;
constexpr size_t WS_NLOC = WS_VCMP + 256 * KiB;
constexpr size_t WS_MSC = WS_NLOC + 256 * KiB;
constexpr size_t WS_XB = 29 * MiB;
static_assert(WS_MSC + 64 * KiB <= WS_XB, "ws map");
constexpr size_t WS_PB = WS_XB + 32 * MiB;
constexpr size_t WS_NARROW = WS_PB + 8 * MiB;
constexpr size_t WS_CLOC = WS_NARROW + 2 * MiB;
constexpr size_t WS_PROJ = WS_CLOC + 16 * MiB;
constexpr size_t WS_END = WS_PROJ + 184 * MiB;
constexpr size_t F_AZ = 0, F_BU = 16 * MiB, F_BV = 32 * MiB, F_BZ = 48 * MiB, F_CQ = 64 * MiB, F_CK = 80 * MiB,
                 F_CV = 96 * MiB, F_CO = 112 * MiB, F_CZ = 128 * MiB, F_AQ = 144 * MiB, F_KV = 160 * MiB;
constexpr size_t S1 = F_AQ, S2 = F_BV, S3 = F_CQ, S4 = F_CV;
constexpr int CW_BAR = 4096;
constexpr int RING_BYTES = 131072, MISC_OFF = 153600, LDS_BYTES = 154624;
constexpr int NPHASE = 17;
namespace pg8 {
#define PG8_LAS __attribute__((address_space(3)))
typedef unsigned short bf16_t;
typedef short bf16x8 __attribute__((ext_vector_type(8)));
typedef float f32x4 __attribute__((ext_vector_type(4)));
typedef unsigned u32x4 __attribute__((ext_vector_type(4)));
constexpr int BM = 256, BK = 64, HALF = 128, HTB = HALF * BK * 2  , STAGE_BYTES = 8 * HTB, NXCD = 8, WGM = 8;

__host__ __device__ __forceinline__ int lds_byte(int r, int c) { const int st = (r >> 4) * 2 + (c >> 5), rr = r & 15, cc = c & 31, ob = rr * 64 + cc * 2; return st * 1024 + (ob ^ (((ob >> 9) & 1) << 5)); }
__host__ __device__ __forceinline__ void stage_rc(int b, int& R, int& C) { const int st = b / 1024, sb = b % 1024, swz = sb ^ (((sb >> 9) & 1) << 5); R = (st >> 1) * 16 + swz / 64; C = (st & 1) * 32 + (swz % 64) / 2; }
__host__ __device__ __forceinline__ int perm32(int rho) { const int n = rho >> 4, i = rho & 15; return 8 * (i >> 2) + 4 * n + (i & 3); }

struct Unit { int pm, pn; };
struct Gemm { const bf16_t* A; const bf16_t* Bt; int M, N, K; };

struct StaticOrder {
    int nM, nN, nwg, G, c;
    __host__ __device__ void init(int M, int N, int G_, int c_) { nM = M / BM; nN = N / BM; nwg = nM * nN; G = G_; c = c_; }
    __host__ __device__ bool next(int i, Unit& u) const {
        const long L = (long)i * G + c; if (L >= nwg) return false;
        int wgid = (int)L; { const int q = nwg / NXCD, r = nwg % NXCD, xcd = wgid % NXCD, off = wgid / NXCD; wgid = (xcd < r ? xcd * (q + 1) : r * (q + 1) + (xcd - r) * q) + off; }
        const int nig = WGM * nN, gid = wgid / nig, fm = gid * WGM, gsz = (nM - fm) < WGM ? (nM - fm) : WGM;
        u.pm = fm + ((wgid % nig) % gsz); u.pn = (wgid % nig) / gsz; return true;
    }
    __device__ __forceinline__ void a_ready(const Unit&) const {}
    __device__ __forceinline__ void done(const Unit&) const {}
};

__device__ __forceinline__ unsigned cvt_pk_bf16(float lo, float hi) { unsigned r; asm volatile("v_cvt_pk_bf16_f32 %0, %1, %2" : "=v"(r) : "v"(lo), "v"(hi)); return r; }
typedef float f32x2 __attribute__((ext_vector_type(2)));
template <class Epi, class Sched, bool ALIGN_EPI = false, bool SP2 = false>
__device__ __forceinline__ void gemm_phase(PG8_LAS unsigned char* lds, const Gemm g, const Sched& S, const Epi& E) {
    int tid_l = threadIdx.x; asm volatile("" : "+v"(tid_l));
    const int tid = tid_l, wid = __builtin_amdgcn_readfirstlane(tid >> 6), lane = tid & 63, wr = wid >> 2, wc = wid & 3, fr = lane & 15, fq = lane >> 4;
    const int K = g.K, nt = K / BK;
    unsigned voffA[2], voffB[2];
#pragma unroll
    for (int i = 0; i < 2; ++i) { int R, C; stage_rc(tid * 16 + i * 8192, R, C); const int Rb = Epi::PERM ? ((R & ~31) + perm32(R & 31)) : R;
        voffA[i] = (unsigned)(R * K + C) * 2u; voffB[i] = (unsigned)(Rb * K + C) * 2u; }
    const size_t kstep = (size_t)(BK * 2);
    const size_t hstep = (size_t)HALF * K * 2;
    const size_t tstep = 2 * hstep;
    const unsigned ldsw = (unsigned)wid * 1024u;
    const int aoff = lds_byte(wr * 64 + fr, fq * 8), boff = lds_byte(wc * 32 + fr, fq * 8);
#define PG8_SA(b, h) (((b) * 2 + (h)) * HTB)
#define PG8_SB(b, h) ((4 + (b) * 2 + (h)) * HTB)
#define PG8_STAGE(bufoff, gbase, voff) do { _Pragma("unroll") for (int _i = 0; _i < 2; ++_i) \
        __builtin_amdgcn_global_load_lds((const unsigned*)((const char*)(gbase) + (voff)[_i]), (PG8_LAS unsigned*)(lds + (bufoff) + ldsw + _i * 8192), 16, 0, 0); } while (0)
#define PG8_LDA(dst, b, h) do { _Pragma("unroll") for (int m = 0; m < 4; ++m) _Pragma("unroll") for (int k = 0; k < 2; ++k) dst[m][k] = *(const PG8_LAS bf16x8*)(lds + PG8_SA(b, h) + aoff + m * 2048 + k * 1024); } while (0)
#define PG8_LDB(dst, b, h) do { _Pragma("unroll") for (int n = 0; n < 2; ++n) _Pragma("unroll") for (int k = 0; k < 2; ++k) dst[n][k] = *(const PG8_LAS bf16x8*)(lds + PG8_SB(b, h) + boff + n * 2048 + k * 1024); } while (0)
#define PG8_MMA(ai, bj, At, Bt) do { __builtin_amdgcn_s_setprio(1); _Pragma("unroll") for (int m = 0; m < 4; ++m) _Pragma("unroll") for (int n = 0; n < 2; ++n) _Pragma("unroll") for (int k = 0; k < 2; ++k) \
        acc[ai][bj][m][n] = __builtin_amdgcn_mfma_f32_16x16x32_bf16(Bt[n][k], At[m][k], acc[ai][bj][m][n], 0, 0, 0); __builtin_amdgcn_s_setprio(0); } while (0)
#define PG8_WAIT_V(n) asm volatile("s_waitcnt vmcnt(" #n ")" ::: "memory")
#define PG8_WAIT_L(n) asm volatile("s_waitcnt lgkmcnt(" #n ")" ::: "memory")
#define PG8_BAR __builtin_amdgcn_s_barrier()
#define PG8_SCHED __builtin_amdgcn_sched_barrier(0)
    Unit cur, nxt; int ui = 0;
    if (!S.next(0, cur)) return;
    f32x4 acc[2][2][4][2];
#pragma unroll
    for (int a = 0; a < 2; ++a)
#pragma unroll
        for (int b = 0; b < 2; ++b)
#pragma unroll
            for (int m = 0; m < 4; ++m)
#pragma unroll
                for (int n = 0; n < 2; ++n) acc[a][b][m][n] = (f32x4){0.f, 0.f, 0.f, 0.f};
    bf16x8 At[4][2], B0[2][2], B1[2][2];
    const char* cA = (const char*)g.A + (size_t)cur.pm * tstep; const char* cB = (const char*)g.Bt + (size_t)cur.pn * tstep;
    S.a_ready(cur);
    if constexpr (SP2) {
        PG8_STAGE(PG8_SB(0, 0), cB, voffB); PG8_STAGE(PG8_SB(0, 1), cB + hstep, voffB); PG8_STAGE(PG8_SA(0, 0), cA, voffA); PG8_STAGE(PG8_SA(0, 1), cA + hstep, voffA);
        if (wr == 1) PG8_BAR;
        PG8_WAIT_V(2); PG8_BAR;
        PG8_STAGE(PG8_SB(1, 0), cB + kstep, voffB); PG8_STAGE(PG8_SA(1, 0), cA + kstep, voffA); PG8_STAGE(PG8_SB(1, 1), cB + hstep + kstep, voffB);
        PG8_WAIT_V(6); PG8_BAR;
    } else {
        PG8_STAGE(PG8_SB(0, 0), cB, voffB); PG8_STAGE(PG8_SA(0, 0), cA, voffA); PG8_STAGE(PG8_SB(0, 1), cB + hstep, voffB); PG8_STAGE(PG8_SA(0, 1), cA + hstep, voffA);
        if (wr == 1) PG8_BAR;
        PG8_WAIT_V(4); PG8_BAR;
        PG8_STAGE(PG8_SB(1, 0), cB + kstep, voffB); PG8_STAGE(PG8_SA(1, 0), cA + kstep, voffA); PG8_STAGE(PG8_SB(1, 1), cB + hstep + kstep, voffB);
        PG8_WAIT_V(6); PG8_BAR;
    }
    for (;;) {
        const bool has_next = S.next(ui + 1, nxt);
        const char* nA = has_next ? (const char*)g.A + (size_t)nxt.pm * tstep : cA; const char* nB = has_next ? (const char*)g.Bt + (size_t)nxt.pn * tstep : cB;
        for (int t = 0; t < nt; t += 2) {
            const bool last = (t == nt - 2);
            const char* a1 = cA + (size_t)(t + 1) * kstep;
            const char* a2 = last ? nA : cA + (size_t)(t + 2) * kstep; const char* b2 = last ? nB : cB + (size_t)(t + 2) * kstep;
            const char* a3 = a2 + kstep; const char* b3 = b2 + kstep;
            if (last && has_next) S.a_ready(nxt);
            if constexpr (SP2) {
            PG8_LDB(B0, 0, 0); PG8_LDB(B1, 0, 1); PG8_SCHED; PG8_LDA(At, 0, 0); PG8_STAGE(PG8_SA(1, 1), a1 + hstep, voffA);
            PG8_WAIT_V(8); PG8_WAIT_L(0); PG8_BAR; PG8_MMA(0, 0, At, B0); PG8_MMA(0, 1, At, B1); PG8_BAR; PG8_SCHED;
            PG8_LDA(At, 0, 1); PG8_STAGE(PG8_SB(0, 0), b2, voffB); PG8_STAGE(PG8_SB(0, 1), b2 + hstep, voffB); PG8_STAGE(PG8_SA(0, 0), a2, voffA);
            PG8_WAIT_V(8); PG8_WAIT_L(0); PG8_BAR; PG8_MMA(1, 0, At, B0); PG8_MMA(1, 1, At, B1); PG8_BAR; PG8_SCHED;
            PG8_LDB(B0, 1, 0); PG8_LDB(B1, 1, 1); PG8_SCHED; PG8_LDA(At, 1, 0); PG8_STAGE(PG8_SA(0, 1), a2 + hstep, voffA);
            PG8_WAIT_V(8); PG8_WAIT_L(0); PG8_BAR; PG8_MMA(0, 0, At, B0); PG8_MMA(0, 1, At, B1); PG8_BAR; PG8_SCHED;
            PG8_LDA(At, 1, 1); PG8_STAGE(PG8_SB(1, 0), b3, voffB); PG8_STAGE(PG8_SB(1, 1), b3 + hstep, voffB); PG8_STAGE(PG8_SA(1, 0), a3, voffA);
            PG8_WAIT_V(8); PG8_WAIT_L(0); PG8_BAR; PG8_MMA(1, 0, At, B0); PG8_MMA(1, 1, At, B1); PG8_BAR; PG8_SCHED;
            } else {
            PG8_LDB(B0, 0, 0); PG8_SCHED; PG8_LDA(At, 0, 0); PG8_STAGE(PG8_SA(1, 1), a1 + hstep, voffA);
            PG8_WAIT_L(8); PG8_BAR; PG8_WAIT_L(0); PG8_MMA(0, 0, At, B0); PG8_BAR; PG8_SCHED;
            PG8_LDB(B1, 0, 1); PG8_STAGE(PG8_SB(0, 0), b2, voffB);
            PG8_BAR; PG8_WAIT_L(0); PG8_MMA(0, 1, At, B1); PG8_BAR;
            PG8_LDA(At, 0, 1); PG8_STAGE(PG8_SA(0, 0), a2, voffA);
            PG8_BAR; PG8_WAIT_L(0); PG8_MMA(1, 0, At, B0); PG8_BAR; PG8_SCHED;
            PG8_STAGE(PG8_SB(0, 1), b2 + hstep, voffB);
            PG8_WAIT_V(6); PG8_BAR; PG8_MMA(1, 1, At, B1); PG8_BAR;
            PG8_LDB(B0, 1, 0); PG8_SCHED; PG8_LDA(At, 1, 0); PG8_STAGE(PG8_SA(0, 1), a2 + hstep, voffA);
            PG8_WAIT_L(8); PG8_BAR; PG8_WAIT_L(0); PG8_MMA(0, 0, At, B0); PG8_BAR; PG8_SCHED;
            PG8_LDB(B1, 1, 1); PG8_STAGE(PG8_SB(1, 0), b3, voffB);
            PG8_BAR; PG8_WAIT_L(0); PG8_MMA(0, 1, At, B1); PG8_BAR;
            PG8_LDA(At, 1, 1); PG8_STAGE(PG8_SA(1, 0), a3, voffA);
            PG8_BAR; PG8_WAIT_L(0); PG8_MMA(1, 0, At, B0); PG8_BAR; PG8_SCHED;
            PG8_STAGE(PG8_SB(1, 1), b3 + hstep, voffB);
            PG8_WAIT_V(6); PG8_BAR; PG8_MMA(1, 1, At, B1); PG8_BAR;
            }
        }
        if constexpr (ALIGN_EPI) { if (wr == 0) PG8_BAR; }
        if constexpr (!Epi::AFTER_DRAIN) { E(acc, cur, wr, wc, fr, fq); S.done(cur); }
        if (!has_next) break;
#pragma unroll
        for (int a = 0; a < 2; ++a)
#pragma unroll
            for (int b = 0; b < 2; ++b)
#pragma unroll
                for (int m = 0; m < 4; ++m)
#pragma unroll
                    for (int n = 0; n < 2; ++n) acc[a][b][m][n] = (f32x4){0.f, 0.f, 0.f, 0.f};
        cur = nxt; cA = nA; cB = nB; ++ui;
        if constexpr (ALIGN_EPI) { if (wr == 1) PG8_BAR; }
    }
    PG8_WAIT_V(0);
    if constexpr (!ALIGN_EPI) { if (wr == 0) PG8_BAR; }
    PG8_BAR;
    if constexpr (Epi::AFTER_DRAIN) { E.fused(acc, cur, wr, wc, fr, fq, lds, wid, lane); S.done(cur); }
#undef PG8_SA
#undef PG8_SB
#undef PG8_STAGE
#undef PG8_LDA
#undef PG8_LDB
#undef PG8_MMA
#undef PG8_WAIT_V
#undef PG8_WAIT_L
#undef PG8_BAR
#undef PG8_SCHED
}
}
namespace pg8 {
typedef unsigned u32x2 __attribute__((ext_vector_type(2)));
typedef float f32x2v_ __attribute__((ext_vector_type(2))); typedef __bf16 bf16x2v_ __attribute__((ext_vector_type(2)));
__device__ __forceinline__ unsigned cvt2(float lo, float hi) { f32x2v_ v = {lo, hi}; bf16x2v_ b = __builtin_convertvector(v, bf16x2v_); return __builtin_bit_cast(unsigned, b); }
__device__ __forceinline__ float sigmoid_f(float x) { return __builtin_amdgcn_rcpf(1.f + __builtin_amdgcn_exp2f(-1.4426950408889634f * x)); }
__device__ __forceinline__ float silu_f(float x) { return x * sigmoid_f(x); }
__device__ __forceinline__ float gelu_tanh_f(float x) { const float u = 0.7978845608028654f * (x + 0.044715f * x * x * x); return x * sigmoid_f(2.f * u); }
__device__ __forceinline__ float bflo(unsigned w) { return __uint_as_float(w << 16); }
__device__ __forceinline__ float bfhi(unsigned w) { return __uint_as_float(w & 0xffff0000u); }
template <int ACT> __device__ __forceinline__ float act_f(float v) {
    if (ACT == 1) return v * 0.125f; if (ACT == 2) return silu_f(v); if (ACT == 3) return gelu_tanh_f(v); if (ACT == 4) return sigmoid_f(v); return v; }
template <int ACT> __device__ __forceinline__ void store_tile_bf16(const f32x4 (&acc)[2][2][4][2], bf16_t* base, int ld, int row0, int col0) {
#pragma unroll
    for (int ai = 0; ai < 2; ++ai)
#pragma unroll
        for (int m = 0; m < 4; ++m) { bf16_t* rowp = base + (size_t)(row0 + ai * HALF + m * 16) * ld + col0;
#pragma unroll
            for (int bj = 0; bj < 2; ++bj) { const f32x4 v0 = acc[ai][bj][m][0], v1 = acc[ai][bj][m][1]; u32x4 w;
                w.x = cvt2(act_f<ACT>(v0[0]), act_f<ACT>(v0[1])); w.y = cvt2(act_f<ACT>(v0[2]), act_f<ACT>(v0[3]));
                w.z = cvt2(act_f<ACT>(v1[0]), act_f<ACT>(v1[1])); w.w = cvt2(act_f<ACT>(v1[2]), act_f<ACT>(v1[3]));
                *(u32x4*)(rowp + bj * HALF) = w; }
            asm volatile("" ::: "memory"); }
}
struct EpiProj {
    static constexpr bool PERM = true, AFTER_DRAIN = false;
    unsigned char* proj; float* narrow;
    __device__ __forceinline__ void operator()(const f32x4 (&acc)[2][2][4][2], const Unit& u, int wr, int wc, int fr, int fq) const {
        const int row0 = u.pm * BM + wr * 64 + fr; const int pn = u.pn;
        if (pn == 23) {
            if (wc == 0) {
#pragma unroll
                for (int ai = 0; ai < 2; ++ai)
#pragma unroll
                    for (int m = 0; m < 4; ++m) { float* rp = narrow + (size_t)(row0 + ai * HALF + m * 16) * 32 + 8 * fq;
#pragma unroll
                        for (int n = 0; n < 2; ++n) { f32x4 v = acc[ai][0][m][n];
                            if (8 * fq + 4 * n < 24) { v[0] = sigmoid_f(v[0]); v[1] = sigmoid_f(v[1]); v[2] = sigmoid_f(v[2]); v[3] = sigmoid_f(v[3]); }
                            *(f32x4*)(rp + 4 * n) = v; } }
            }
            return;
        }
        size_t fo; int ld, cin, act;
        if (pn < 2) { fo = F_AQ; ld = 512; cin = pn * 256; act = 1; }
        else if (pn < 5) { fo = F_KV; ld = 768; cin = (pn - 2) * 256; act = 0; }
        else { const int f = (pn - 5) >> 1; fo = F_AZ + (size_t)f * (16 * MiB); ld = 512; cin = ((pn - 5) & 1) * 256; act = (int)((0x240002332ull >> (4 * f)) & 0xFull); }
        bf16_t* base = (bf16_t*)(proj + fo); const int col0 = cin + wc * 32 + 8 * fq;
        switch (act) {
            case 0: store_tile_bf16<0>(acc, base, ld, row0, col0); break;
            case 1: store_tile_bf16<1>(acc, base, ld, row0, col0); break;
            case 2: store_tile_bf16<2>(acc, base, ld, row0, col0); break;
            case 3: store_tile_bf16<3>(acc, base, ld, row0, col0); break;
            default: store_tile_bf16<4>(acc, base, ld, row0, col0); break;
        }
    }
};
struct EpiGate {
    static constexpr bool PERM = true, AFTER_DRAIN = false;
    unsigned char* proj;
    __device__ __forceinline__ void operator()(const f32x4 (&acc)[2][2][4][2], const Unit& u, int wr, int wc, int fr, int fq) const {
        const int br = u.pn >> 2; bf16_t* base = (bf16_t*)(proj + (br ? S2 + (size_t)(br - 1) * (S3 - S2) : S1));
        store_tile_bf16<4>(acc, base, 1024, u.pm * BM + wr * 64 + fr, (u.pn & 3) * 256 + wc * 32 + 8 * fq);
    }
};
template <bool FIRST> struct EpiBranch {
    static constexpr bool PERM = true, AFTER_DRAIN = false;
    const bf16_t* G; bf16_t* mg; float scale;
    __device__ __forceinline__ void operator()(const f32x4 (&acc)[2][2][4][2], const Unit& u, int wr, int wc, int fr, int fq) const {
        const int row0 = u.pm * BM + wr * 64 + fr, col0 = u.pn * 256 + wc * 32 + 8 * fq;
#pragma unroll
        for (int ai = 0; ai < 2; ++ai)
#pragma unroll
            for (int m = 0; m < 4; ++m) { const size_t ro = (size_t)(row0 + ai * HALF + m * 16) * 1024 + col0;
#pragma unroll
                for (int bj = 0; bj < 2; ++bj) { const f32x4 v0 = acc[ai][bj][m][0], v1 = acc[ai][bj][m][1];
                    const u32x4 g = *(const u32x4*)(G + ro + bj * HALF);
                    float o[8] = { v0[0] * bflo(g.x), v0[1] * bfhi(g.x), v0[2] * bflo(g.y), v0[3] * bfhi(g.y), v1[0] * bflo(g.z), v1[1] * bfhi(g.z), v1[2] * bflo(g.w), v1[3] * bfhi(g.w) };
#pragma unroll
                    for (int j = 0; j < 8; ++j) o[j] *= scale;
                    if (!FIRST) { const u32x4 p = *(const u32x4*)(mg + ro + bj * HALF);
                        o[0] += bflo(p.x); o[1] += bfhi(p.x); o[2] += bflo(p.y); o[3] += bfhi(p.y); o[4] += bflo(p.z); o[5] += bfhi(p.z); o[6] += bflo(p.w); o[7] += bfhi(p.w); }
                    u32x4 w; w.x = cvt2(o[0], o[1]); w.y = cvt2(o[2], o[3]); w.z = cvt2(o[4], o[5]); w.w = cvt2(o[6], o[7]);
                    *(u32x4*)(mg + ro + bj * HALF) = w; }
                asm volatile("" ::: "memory"); }
    }
};
struct EpiOut {
    static constexpr bool PERM = false, AFTER_DRAIN = false;
    const float* xres; float* out; bf16_t* xb; float alpha;
    __device__ __forceinline__ void operator()(const f32x4 (&acc)[2][2][4][2], const Unit& u, int wr, int wc, int fr, int fq) const {
        const int row0 = u.pm * BM + wr * 64 + fr, col0 = u.pn * 256 + wc * 32 + 4 * fq;
#pragma unroll
        for (int ai = 0; ai < 2; ++ai)
#pragma unroll
            for (int m = 0; m < 4; ++m) { const size_t ro = (size_t)(row0 + ai * HALF + m * 16) * 1024 + col0;
#pragma unroll
                for (int bj = 0; bj < 2; ++bj)
#pragma unroll
                    for (int n = 0; n < 2; ++n) { const size_t o = ro + bj * HALF + n * 16; const f32x4 xi = *(const f32x4*)(xres + o);
                        const f32x4 r = xi * alpha + acc[ai][bj][m][n]; *(f32x4*)(out + o) = r;
                        u32x2 w; w.x = cvt2(r[0], r[1]); w.y = cvt2(r[2], r[3]); *(u32x2*)(xb + o) = w; }
                asm volatile("" ::: "memory"); }
    }
};
struct EpiPw {
    static constexpr bool PERM = true, AFTER_DRAIN = false;
    bf16_t* pw;
    __device__ __forceinline__ void operator()(const f32x4 (&acc)[2][2][4][2], const Unit& u, int wr, int wc, int fr, int fq) const {
        store_tile_bf16<0>(acc, pw, 1024, u.pm * BM + wr * 64 + fr, u.pn * 256 + wc * 32 + 8 * fq);
    }
};
struct EpiPle {
    static constexpr bool PERM = false, AFTER_DRAIN = false;
    float* out; const bf16_t* pw;
    __device__ __forceinline__ void operator()(const f32x4 (&acc)[2][2][4][2], const Unit& u, int wr, int wc, int fr, int fq) const {
        const int row0 = u.pm * BM + wr * 64 + fr, col0 = u.pn * 256 + wc * 32 + 4 * fq;
#pragma unroll
        for (int ai = 0; ai < 2; ++ai)
#pragma unroll
            for (int m = 0; m < 4; ++m) { const size_t ro = (size_t)(row0 + ai * HALF + m * 16) * 1024 + col0;
#pragma unroll
                for (int bj = 0; bj < 2; ++bj)
#pragma unroll
                    for (int n = 0; n < 2; ++n) { const size_t o = ro + bj * HALF + n * 16; f32x4 r = *(const f32x4*)(out + o); const u32x2 p = *(const u32x2*)(pw + o);
                        const f32x4 a = acc[ai][bj][m][n];
                        r[0] += sigmoid_f(a[0]) * bflo(p.x); r[1] += sigmoid_f(a[1]) * bfhi(p.x); r[2] += sigmoid_f(a[2]) * bflo(p.y); r[3] += sigmoid_f(a[3]) * bfhi(p.y);
                        *(f32x4*)(out + o) = r; }
                asm volatile("" ::: "memory"); }
    }
};
}
#define GAS __attribute__((address_space(1)))
#define LAS __attribute__((address_space(3)))
typedef unsigned short bf16;
typedef unsigned v4u __attribute__((ext_vector_type(4)));
typedef float f32x4 __attribute__((ext_vector_type(4)));
typedef short bf16x8 __attribute__((ext_vector_type(8)));
typedef GAS unsigned gu32;
typedef GAS unsigned long long gu64;
#define RLX_AGENT __ATOMIC_RELAXED, __HIP_MEMORY_SCOPE_AGENT
#define LDS_WAIT() asm volatile("s_waitcnt lgkmcnt(0)" ::: "memory")
#define VM_WAIT() asm volatile("s_waitcnt vmcnt(0)" ::: "memory")
__device__ __forceinline__ unsigned long long rt() { return __builtin_amdgcn_s_memrealtime(); }
__device__ __forceinline__ unsigned f2bf(float f) { unsigned u = __builtin_bit_cast(unsigned, f); return (u + 0x7fffu + ((u >> 16) & 1u)) >> 16; }
__device__ __forceinline__ unsigned pk2(float lo, float hi) { return f2bf(lo) | (f2bf(hi) << 16); }
#define XB_TMO      128
#define XB_XCNT(j)  (256  + 64 * (j))
#define XB_XSUB(j)  (1280 + 64 * (j))
#define XB_XGEN(j)  (2304 + 64 * (j))
#define XB_TOP      3328
#define XB_TOPGEN   3392
#define XCD_BAR_WORDS 3456
#define XB_SPIN_CAP (1u << 18)

__device__ __forceinline__ unsigned xb_ld(unsigned* p)              { return __hip_atomic_load(p, __ATOMIC_RELAXED, __HIP_MEMORY_SCOPE_AGENT); }
__device__ __forceinline__ unsigned xb_add(unsigned* p, unsigned v) { return __hip_atomic_fetch_add(p, v, __ATOMIC_RELAXED, __HIP_MEMORY_SCOPE_AGENT); }
__device__ __forceinline__ unsigned xb_xcc_id() { return (unsigned)__builtin_amdgcn_s_getreg((3 << 11) | 20) & 0xFu; }
#define XB_SPIN(cond, bar) do { unsigned _sp = 0; while (cond) { __builtin_amdgcn_s_sleep(1); \
    if ((++_sp & 255u) == 0u) { if (xb_ld(&(bar)[XB_TMO])) break; if (_sp > XB_SPIN_CAP) { atomicAdd(&(bar)[XB_TMO], 1u); break; } } } } while (0)

struct XcdBarrier {
    unsigned* bar; unsigned x;
    volatile LAS unsigned* st;
};

__device__ __forceinline__ XcdBarrier xcd_barrier_post(unsigned* bar, volatile LAS unsigned* st) {
    XcdBarrier b; b.bar = bar; b.x = xb_xcc_id(); b.st = st;
    if (threadIdx.x == 0) (void)xb_add(&bar[XB_XCNT(b.x)], 1u);
    return b;
}
__device__ __forceinline__ void xcd_barrier_complete(unsigned* bar, unsigned x, unsigned& nloc, unsigned& nx) {
    const unsigned G = gridDim.x * gridDim.y * gridDim.z;
    unsigned sum, cnt, mine, sp = 0u;
    for (;;) {
        sum = 0u; cnt = 0u; mine = 0u;
#pragma unroll
        for (unsigned j = 0; j < 16; ++j) { const unsigned c = xb_ld(&bar[XB_XCNT(j)]); sum += c; cnt += (c > 0u) ? 1u : 0u; mine = (j == x) ? c : mine; }
        if (sum == G) break;
        __builtin_amdgcn_s_sleep(1);
        if ((++sp & 255u) == 0u) { if (xb_ld(&bar[XB_TMO])) break; if (sp > XB_SPIN_CAP) { atomicAdd(&bar[XB_TMO], 1u); break; } }
    }
    nloc = mine > 0u ? mine : 1u; nx = cnt > 0u ? cnt : 1u;
}

__device__ __forceinline__ void xcd_barrier(const XcdBarrier& b) {
    asm volatile("s_waitcnt vmcnt(0)" ::: "memory");
    __syncthreads();
    if (threadIdx.x == 0) {
        unsigned* bar = b.bar;
        __builtin_amdgcn_s_waitcnt(0);
        unsigned nloc = b.st[0], nx = b.st[1];
        if (nloc == 0u) { xcd_barrier_complete(bar, b.x, nloc, nx); b.st[0] = nloc; b.st[1] = nx; }
        const unsigned old = xb_add(&bar[XB_XSUB(b.x)], 1u);
        const unsigned gen = old / nloc;
        if (old + 1u == (gen + 1u) * nloc) {
            __builtin_amdgcn_fence(__ATOMIC_RELEASE, "agent");
            asm volatile("s_waitcnt vmcnt(0)" ::: "memory");
            const unsigned og = xb_add(&bar[XB_TOP], 1u);
            const unsigned tg = og / nx;
            if (og + 1u == (tg + 1u) * nx) xb_add(&bar[XB_TOPGEN], 1u);
            else XB_SPIN(xb_ld(&bar[XB_TOPGEN]) == tg, bar);
            __builtin_amdgcn_fence(__ATOMIC_ACQUIRE, "agent");
            xb_add(&bar[XB_XGEN(b.x)], 1u);
            asm volatile("s_waitcnt vmcnt(0)" ::: "memory");
        } else {
            XB_SPIN(xb_ld(&bar[XB_XGEN(b.x)]) == gen, bar);
            __builtin_amdgcn_fence(__ATOMIC_ACQUIRE, "agent");
            asm volatile("s_waitcnt vmcnt(0)" ::: "memory");
        }
    }
    __syncthreads();
}
typedef short v4i16_t __attribute__((ext_vector_type(4)));
typedef unsigned u32x2 __attribute__((ext_vector_type(2)));
typedef float f32x2_t __attribute__((ext_vector_type(2)));
typedef __bf16 bf16x2_t __attribute__((ext_vector_type(2)));
typedef LAS unsigned char* lds_t;
__device__ __forceinline__ unsigned cvtpk(float lo, float hi) { f32x2_t v = {lo, hi}; bf16x2_t b = __builtin_convertvector(v, bf16x2_t); return __builtin_bit_cast(unsigned, b); }
__device__ __forceinline__ float bflo(unsigned w) { return __uint_as_float(w << 16); }
__device__ __forceinline__ float bfhi(unsigned w) { return __uint_as_float(w & 0xffff0000u); }
__device__ __forceinline__ void unpack8(const v4u w, float (&f)[8]) { f[0] = bflo(w.x); f[1] = bfhi(w.x); f[2] = bflo(w.y); f[3] = bfhi(w.y); f[4] = bflo(w.z); f[5] = bfhi(w.z); f[6] = bflo(w.w); f[7] = bfhi(w.w); }
__device__ __forceinline__ v4u pack8(const float (&f)[8]) { v4u w; w.x = cvtpk(f[0], f[1]); w.y = cvtpk(f[2], f[3]); w.z = cvtpk(f[4], f[5]); w.w = cvtpk(f[6], f[7]); return w; }
__device__ __forceinline__ float sigm(float x) { return __builtin_amdgcn_rcpf(1.f + __builtin_amdgcn_exp2f(-L2E * x)); }
__device__ __forceinline__ float siluf(float x) { return x * sigm(x); }
__device__ __forceinline__ float gelut(float x) { const float u = 0.7978845608028654f * (x + 0.044715f * x * x * x); return x * sigm(2.f * u); }
__device__ __forceinline__ f32x4 mfma16(bf16x8 a, bf16x8 b, f32x4 c) { return __builtin_amdgcn_mfma_f32_16x16x32_bf16(a, b, c, 0, 0, 0); }
__device__ __forceinline__ v4i16_t trd(lds_t p) { return __builtin_amdgcn_ds_read_tr16_b64_v4i16((LAS v4i16_t*)p); }
__device__ __forceinline__ bf16x8 tr_pair(lds_t base, int stride, int rowb, int col, int fr, int Q) {
    lds_t p = base + (rowb + 4 * Q + (fr >> 2)) * stride + (col + 4 * (fr & 3)) * 2;
    const v4i16_t a = trd(p), b = trd(p + 16 * stride);
    return (bf16x8){a[0], a[1], a[2], a[3], b[0], b[1], b[2], b[3]};
}
__device__ __forceinline__ bf16x8 mk_frag(u32x2 a, u32x2 b) { v4u w; w.x = a.x; w.y = a.y; w.z = b.x; w.w = b.y; return __builtin_bit_cast(bf16x8, w); }
__device__ __forceinline__ float logsigf(float x) { return fminf(x, 0.f) - log1pf(expf(-fabsf(x))); }
__device__ __forceinline__ const float* ld_ptr(const LAS unsigned long long* t, int k) {
    const unsigned long long v = t[k];
    const unsigned lo = __builtin_amdgcn_readfirstlane((unsigned)v), hi = __builtin_amdgcn_readfirstlane((unsigned)(v >> 32));
    return (const float*)(const GAS float*)(uintptr_t)(((unsigned long long)hi << 32) | lo);
}
__device__ __forceinline__ float wave_sum(float v) {
#pragma unroll
    for (int o = 1; o < 64; o <<= 1) v += __shfl_xor(v, o);
    return v;
}
__device__ __forceinline__ void tr_item(const float* W, int ldw, bf16* WT, int K, int row_off, LAS float* scr, int kb, int nb, int lane) {
    const int k0 = 64 * kb, n0 = 32 * nb;
#pragma unroll 8
    for (int i = 0; i < 32; ++i) { const int kk = 2 * i + (lane >> 5); scr[kk * 33 + (lane & 31)] = W[(size_t)(k0 + kk) * ldw + n0 + (lane & 31)]; }
    LDS_WAIT(); asm volatile("" ::: "memory");
    const int c = lane & 7;
#pragma unroll
    for (int j = 0; j < 4; ++j) { const int n = (lane >> 3) + 8 * j; const LAS float* s = scr + (8 * c) * 33 + n;
        v4u o; o.x = cvtpk(s[0 * 33], s[1 * 33]); o.y = cvtpk(s[2 * 33], s[3 * 33]); o.z = cvtpk(s[4 * 33], s[5 * 33]); o.w = cvtpk(s[6 * 33], s[7 * 33]);
        *(v4u*)(WT + (size_t)(row_off + n0 + n) * K + k0 + 8 * c) = o; }
    LDS_WAIT(); asm volatile("" ::: "memory");
}
__device__ __forceinline__ void cvt_rows(const float* src, bf16* dst, size_t n8, size_t gt, size_t ngt) {
    for (size_t i = gt; i < n8; i += ngt) { const f32x4 a = *(const f32x4*)(src + 8 * i), b = *(const f32x4*)(src + 8 * i + 4);
        v4u o; o.x = cvtpk(a[0], a[1]); o.y = cvtpk(a[2], a[3]); o.z = cvtpk(b[0], b[1]); o.w = cvtpk(b[2], b[3]); *(v4u*)(dst + 8 * i) = o; }
}
__device__ __forceinline__ void conv_layer(const LAS unsigned long long* ptab, unsigned char* ws, int L, lds_t lds, int vcu, int G, int tid, int lane, int wave) {
    LAS float* scr = (LAS float*)(lds + wave * 16384);
    const int gw = vcu * 8 + wave, NGW = G * 8;
    const float* w_in = ld_ptr(ptab, 2) + (size_t)L * 1024 * NIN;
    bf16* WIN = (bf16*)(ws + WS_WIN); bf16* WBR = (bf16*)(ws + WS_WBR);
    constexpr int I0 = 16 * 40, I1 = 16 * 112, I2 = 16 * 32, I3 = 16 * 96, IBR = 8 * 32, IO = 16 * 32, IPW = 4 * 32, IC1 = 32 * 4, IC2 = 2 * 2;
    constexpr int NITEMS = I0 + I1 + I2 + I3 + 3 * IBR + 2 * IO + IPW + 2 * IC1 + 2 * IC2;
#define TR_JOB(Wp, ldw, K, ncols, WTp, roff) { constexpr int ni_ = ((K) / 64) * ((ncols) / 32); if (r < ni_) { tr_item((Wp), (ldw), (WTp), (K), (roff), scr, r / ((ncols) / 32), r % ((ncols) / 32), lane); continue; } r -= ni_; }
    for (int it = gw; it < NITEMS; it += NGW) {
        int r = it;
        TR_JOB(w_in + 0, NIN, 1024, 1280, WIN, 0)
        TR_JOB(w_in + 1304, NIN, 1024, 3584, WIN, 1280)
        TR_JOB(w_in + 4896, NIN, 1024, 1024, WIN, 4864)
        TR_JOB(w_in + 5920, NIN, 1024, 3072, WIN, 6144)
        TR_JOB(ld_ptr(ptab, 18) + (size_t)L * 512 * 1024, 1024, 512, 1024, WBR, 0)
        TR_JOB(ld_ptr(ptab, 19) + (size_t)L * 512 * 1024, 1024, 512, 1024, WBR + 1024 * 512, 0)
        TR_JOB(ld_ptr(ptab, 20) + (size_t)L * 512 * 1024, 1024, 512, 1024, WBR + 2 * 1024 * 512, 0)
        TR_JOB(ld_ptr(ptab, 21) + (size_t)L * 1024 * 1024, 1024, 1024, 1024, (bf16*)(ws + WS_WOUT), 0)
        TR_JOB(ld_ptr(ptab, 23) + (size_t)L * 1024 * 1024, 1024, 1024, 1024, (bf16*)(ws + WS_WPG), 0)
        TR_JOB(ld_ptr(ptab, 22) + (size_t)L * 256 * 1024, 1024, 256, 1024, (bf16*)(ws + WS_WPW), 0)
        TR_JOB(ld_ptr(ptab, 5) + (size_t)L * 2048 * 128, 128, 2048, 128, (bf16*)(ws + WS_CW1), 0)
        TR_JOB(ld_ptr(ptab, 7) + (size_t)L * 2048 * 128, 128, 2048, 128, (bf16*)(ws + WS_CW1) + 128 * 2048, 0)
        TR_JOB(ld_ptr(ptab, 6) + (size_t)L * 128 * 64, 64, 128, 64, (bf16*)(ws + WS_CW2), 0)
        TR_JOB(ld_ptr(ptab, 8) + (size_t)L * 128 * 64, 64, 128, 64, (bf16*)(ws + WS_CW2) + 64 * 128, 0)
    }
#undef TR_JOB
    const size_t gt = (size_t)vcu * 512 + tid, ngt = (size_t)G * 512;
    for (size_t i = gt; i < (size_t)256 * 1024; i += ngt) { const int rr = (int)(i >> 10), k = (int)(i & 1023);
        float v = 0.f; if (rr < 24) v = w_in[(size_t)k * NIN + 1280 + rr]; else if (rr < 32) v = w_in[(size_t)k * NIN + 4888 + (rr - 24)];
        WIN[(size_t)(5888 + rr) * 1024 + k] = (bf16)(cvtpk(v, 0.f) & 0xffffu); }
    { const float* sgw = ld_ptr(ptab, 11) + (size_t)L * 4 * 128 * 128; bf16* o = (bf16*)(ws + WS_SGW);
      for (size_t i = gt; i < (size_t)4 * 128 * 128; i += ngt) { const int s = (int)(i & 127), t = (int)((i >> 7) & 127); const float v = (s <= t) ? sgw[i] : 0.f; o[i] = (bf16)(cvtpk(v, 0.f) & 0xffffu); } }
    cvt_rows(ld_ptr(ptab, 1) + (size_t)L * M * PLE, (bf16*)(ws + WS_PB), (size_t)M * PLE / 8, gt, ngt);
}
__device__ __forceinline__ void ln_row(const float* xrow, float* orow, bf16* brow, const float* g, const float* bta, int lane) {
    const f32x4* xr = (const f32x4*)xrow + lane;
    f32x4 v[4]; float s = 0.f;
#pragma unroll
    for (int j = 0; j < 4; ++j) { v[j] = xr[64 * j]; s += (v[j][0] + v[j][1]) + (v[j][2] + v[j][3]); }
    const float mean = wave_sum(s) * (1.f / 1024.f); float s2 = 0.f;
#pragma unroll
    for (int j = 0; j < 4; ++j) { v[j] = v[j] - mean; s2 += (v[j][0] * v[j][0] + v[j][1] * v[j][1]) + (v[j][2] * v[j][2] + v[j][3] * v[j][3]); }
    const float rstd = 1.f / sqrtf(wave_sum(s2) * (1.f / 1024.f) + LN_EPS);
#pragma unroll
    for (int j = 0; j < 4; ++j) { const f32x4 gg = *((const f32x4*)g + lane + 64 * j), bb = *((const f32x4*)bta + lane + 64 * j);
        const f32x4 o = v[j] * rstd * gg + bb; *((f32x4*)orow + lane + 64 * j) = o;
        u32x2 w; w.x = cvtpk(o[0], o[1]); w.y = cvtpk(o[2], o[3]); *((u32x2*)brow + lane + 64 * j) = w; }
}
constexpr int TS = 288;
constexpr int TILE_B = 128 * TS;

__device__ __forceinline__ void gmlp_item(lds_t lds, int item, bf16* BU, const bf16* BV, const bf16* BZ, const float* lng, const float* lnb, const bf16* sgw, const float* sgb,
                                          int tid, int lane, int wave) {
    const int g = item & 3, c = (item >> 2) & 15, b = item >> 6;
    const size_t tok0 = (size_t)b * T + c * 128;
    LAS float* stats = (LAS float*)(lds + 40960);
    {
        const int s = tid >> 2, part = tid & 3; const bf16* p = BV + (tok0 + s) * 512 + part * 128; float sum = 0.f, sq = 0.f;
#pragma unroll
        for (int i = 0; i < 16; ++i) { const v4u w = *(const v4u*)(p + 8 * i); float f[8]; unpack8(w, f);
#pragma unroll
            for (int j = 0; j < 8; ++j) { sum += f[j]; sq += f[j] * f[j]; } }
        sum += __shfl_xor(sum, 1); sum += __shfl_xor(sum, 2); sq += __shfl_xor(sq, 1); sq += __shfl_xor(sq, 2);
        const float mean = sum * (1.f / 512.f), var = fmaxf(sq * (1.f / 512.f) - mean * mean, 0.f);
        if (part == 0) { stats[2 * s] = mean; stats[2 * s + 1] = 1.f / sqrtf(var + LN_EPS); }
    }
    __syncthreads();
#pragma unroll
    for (int i = 0; i < 4; ++i) {
        const int idx = tid + 512 * i, s = idx >> 4, ch = idx & 15; const int col = g * 128 + 8 * ch;
        const v4u w = *(const v4u*)(BV + (tok0 + s) * 512 + col); float f[8]; unpack8(w, f);
        const float mean = stats[2 * s], rstd = stats[2 * s + 1];
        const f32x4 g0 = *(const f32x4*)(lng + col), g1 = *(const f32x4*)(lng + col + 4), b0 = *(const f32x4*)(lnb + col), b1 = *(const f32x4*)(lnb + col + 4);
#pragma unroll
        for (int j = 0; j < 4; ++j) { f[j] = (f[j] - mean) * rstd * g0[j] + b0[j]; f[4 + j] = (f[4 + j] - mean) * rstd * g1[j] + b1[j]; }
        *(LAS v4u*)(lds + s * TS + ch * 16) = pack8(f);
    }
    __syncthreads();
    const int fr = lane & 15, Q = lane >> 4, tl = 16 * wave + fr;
    f32x4 acc[8];
#pragma unroll
    for (int n = 0; n < 8; ++n) acc[n] = (f32x4){0.f, 0.f, 0.f, 0.f};
    const bf16* wrow = sgw + (size_t)(g * 128 + tl) * 128;
    const int nk = (wave >> 1) + 1;
    for (int kk = 0; kk < nk; ++kk) {
        const u32x2 b0 = *(const u32x2*)(wrow + 32 * kk + 4 * Q), b1 = *(const u32x2*)(wrow + 32 * kk + 16 + 4 * Q);
        const bf16x8 bfr = mk_frag(b0, b1);
#pragma unroll
        for (int n = 0; n < 8; ++n) acc[n] = mfma16(tr_pair(lds, TS, 32 * kk, 16 * n, fr, Q), bfr, acc[n]);
    }
    const float bias = sgb[g * 128 + tl]; const size_t tok = tok0 + tl;
#pragma unroll
    for (int n = 0; n < 8; ++n) { const size_t off = tok * 512 + g * 128 + 16 * n + 4 * Q;
        const u32x2 u = *(const u32x2*)(BU + off), z = *(const u32x2*)(BZ + off);
        u32x2 w; w.x = cvtpk(bflo(u.x) * (acc[n][0] + bias) * bflo(z.x), bfhi(u.x) * (acc[n][1] + bias) * bfhi(z.x));
        w.y = cvtpk(bflo(u.y) * (acc[n][2] + bias) * bflo(z.y), bfhi(u.y) * (acc[n][3] + bias) * bfhi(z.y));
        *(u32x2*)(BU + off) = w; }
    __syncthreads();
}

__device__ __forceinline__ void mlstm_gates(LAS float* garr, const float* narrow, size_t tok0, int h, float bi, float bfo, int lane) {
    const float* p0 = narrow + (tok0 + 2 * lane) * 32;
    const float li0 = p0[24 + h] + bi, li1 = p0[32 + 24 + h] + bi;
    const float lf0 = logsigf(p0[28 + h] + bfo), lf1 = logsigf(p0[32 + 28 + h] + bfo);
    const float c1 = lf0 + lf1; float run = c1;
#pragma unroll
    for (int o = 1; o < 64; o <<= 1) { const float t = __shfl_up(run, o); if (lane >= o) run += t; }
    const float ex = run - c1, bc0 = ex + lf0, bc1 = ex + c1;
    const float a0 = li0 - bc0, a1 = li1 - bc1; const float m1 = fmaxf(a0, a1); float rm = m1;
#pragma unroll
    for (int o = 1; o < 64; o <<= 1) { const float t = __shfl_up(rm, o); if (lane >= o) rm = fmaxf(rm, t); }
    float pe = __shfl_up(rm, 1); if (lane == 0) pe = -INFINITY;
    garr[2 * lane] = bc0; garr[2 * lane + 1] = bc1; garr[128 + 2 * lane] = a0; garr[128 + 2 * lane + 1] = a1;
    garr[256 + 2 * lane] = fmaxf(pe, a0); garr[256 + 2 * lane + 1] = rm;
}
__device__ __forceinline__ void stage_conv(lds_t dst, const bf16* src, size_t tok0, int tin0, int h, const float* cw, const float* cb, float scale, int tid) {
    const int ch = tid & 15, col = h * 128 + 8 * ch;
    float w[4][8], bb[8];
#pragma unroll
    for (int wi = 0; wi < 4; ++wi) { const f32x4 x0 = *(const f32x4*)(cw + wi * 1024 + col), x1 = *(const f32x4*)(cw + wi * 1024 + col + 4);
#pragma unroll
        for (int j = 0; j < 4; ++j) { w[wi][j] = x0[j]; w[wi][4 + j] = x1[j]; } }
    { const f32x4 x0 = *(const f32x4*)(cb + col), x1 = *(const f32x4*)(cb + col + 4);
#pragma unroll
      for (int j = 0; j < 4; ++j) { bb[j] = x0[j]; bb[4 + j] = x1[j]; } }
#pragma unroll
    for (int i = 0; i < 4; ++i) { const int s = (tid >> 4) + 32 * i; float a[8];
#pragma unroll
        for (int j = 0; j < 8; ++j) a[j] = bb[j];
#pragma unroll
        for (int wi = 0; wi < 4; ++wi) { const int ts = s - 3 + wi;
            if (tin0 + ts >= 0) { const v4u x = *(const v4u*)(src + (size_t)((long)tok0 + ts) * 512 + col); float f[8]; unpack8(x, f);
#pragma unroll
                for (int j = 0; j < 8; ++j) a[j] += w[wi][j] * f[j]; } }
#pragma unroll
        for (int j = 0; j < 8; ++j) a[j] = siluf(a[j]) * scale;
        *(LAS v4u*)(dst + s * TS + ch * 16) = pack8(a); }
}

__device__ __forceinline__ void mlstm1_item(lds_t lds, int item, const bf16* CK, const bf16* CV, const float* narrow, const float* cw, const float* cb, const float* b_i, const float* b_f,
                                            bf16* cloc, float* nloc, float* msc, int tid, int lane, int wave) {
    const int c = item & 15, h = (item >> 4) & 3, b = item >> 6;
    const size_t tok0 = (size_t)b * T + c * 128;
    lds_t Ks = lds, Vs = lds + TILE_B; LAS float* garr = (LAS float*)(lds + 2 * TILE_B); LAS float* red = garr + 384;
    if (wave == 0) mlstm_gates(garr, narrow, tok0, h, b_i[h], b_f[h], lane);
    stage_conv(Ks, CK, tok0, c * 128, h, cw + 512, cb + 512, 0.08838834764831845f, tid);
    __syncthreads();
    const float pm = garr[256 + 127], bl = garr[127];
#pragma unroll
    for (int i = 0; i < 4; ++i) { const int idx = tid + 512 * i, s = idx >> 4, ch = idx & 15;
        const float e = expf(garr[128 + s] - pm);
        const v4u x = *(const v4u*)(CV + (tok0 + s) * 512 + h * 128 + 8 * ch); float f[8]; unpack8(x, f);
#pragma unroll
        for (int j = 0; j < 8; ++j) f[j] *= e;
        *(LAS v4u*)(Vs + s * TS + ch * 16) = pack8(f); }
    {
        const int k = tid & 127, part = tid >> 7; float sacc = 0.f;
        for (int s = 32 * part; s < 32 * part + 32; ++s) { const float e = expf(garr[128 + s] - pm); const unsigned short kv = *(const LAS unsigned short*)(Ks + s * TS + k * 2); sacc += e * __uint_as_float((unsigned)kv << 16); }
        red[part * 128 + k] = sacc;
    }
    __syncthreads();
    const int fr = lane & 15, Q = lane >> 4;
    f32x4 acc[8];
#pragma unroll
    for (int n = 0; n < 8; ++n) acc[n] = (f32x4){0.f, 0.f, 0.f, 0.f};
#pragma unroll
    for (int kk = 0; kk < 4; ++kk) { const bf16x8 bfr = tr_pair(Vs, TS, 32 * kk, 16 * wave, fr, Q);
#pragma unroll
        for (int kt = 0; kt < 8; ++kt) acc[kt] = mfma16(tr_pair(Ks, TS, 32 * kk, 16 * kt, fr, Q), bfr, acc[kt]); }
    { const int v = 16 * wave + fr; bf16* dst = cloc + ((size_t)item * 128 + v) * 128;
#pragma unroll
      for (int kt = 0; kt < 8; ++kt) { u32x2 w; w.x = cvtpk(acc[kt][0], acc[kt][1]); w.y = cvtpk(acc[kt][2], acc[kt][3]); *(u32x2*)(dst + 16 * kt + 4 * Q) = w; } }
    if (tid < 128) nloc[(size_t)item * 128 + tid] = (red[tid] + red[128 + tid]) + (red[256 + tid] + red[384 + tid]);
    if (tid == 0) { msc[2 * item] = bl + pm; msc[2 * item + 1] = bl; }
    __syncthreads();
}

__device__ __forceinline__ void mlstm3_item(lds_t lds, int item, const bf16* CQ, const bf16* CK, const bf16* CV, const bf16* CO, bf16* CZ, const float* narrow, const float* cw, const float* cb,
                                            const float* b_i, const float* b_f, const float* norm_g, const bf16* cloc, const float* nloc, const float* msc, int tid, int lane, int wave) {
    const int c = item & 15, h = (item >> 4) & 3, b = item >> 6, bh = item >> 4;
    const size_t tok0 = (size_t)b * T + c * 128;
    lds_t Qs = lds, Ks = lds + TILE_B, Vs = lds + 2 * TILE_B, Cp = lds + 3 * TILE_B; LAS float* garr = (LAS float*)(lds + 4 * TILE_B); LAS float* npv = garr + 384;
    float mp = 0.f;
    for (int j = 0; j < c; ++j) { const float ml = msc[2 * (bh * 16 + j)], blj = msc[2 * (bh * 16 + j) + 1]; mp = fmaxf(blj + mp, ml); }
    if (wave == 0) mlstm_gates(garr, narrow, tok0, h, b_i[h], b_f[h], lane);
    stage_conv(Qs, CQ, tok0, c * 128, h, cw, cb, 1.0f, tid);
    stage_conv(Ks, CK, tok0, c * 128, h, cw + 512, cb + 512, 0.08838834764831845f, tid);
#pragma unroll
    for (int i = 0; i < 4; ++i) { const int idx = tid + 512 * i, s = idx >> 4, ch = idx & 15;
        *(LAS v4u*)(Vs + s * TS + ch * 16) = *(const v4u*)(CV + (tok0 + s) * 512 + h * 128 + 8 * ch); }
    float zf = 0.f; asm volatile("" : "+v"(zf));
#pragma unroll
    for (int i = 0; i < 4; ++i) { const int idx = tid + 512 * i, v = idx >> 4, ch = idx & 15; float a[8];
#pragma unroll
        for (int j = 0; j < 8; ++j) a[j] = zf;
        float S = 0.f;
        for (int j = c - 1; j >= 0; --j) { const float ml = msc[2 * (bh * 16 + j)], blj = msc[2 * (bh * 16 + j) + 1]; const float w = expf(S + ml - mp);
            const v4u x = *(const v4u*)(cloc + ((size_t)(bh * 16 + j) * 128 + v) * 128 + 8 * ch); float f[8]; unpack8(x, f);
#pragma unroll
            for (int q = 0; q < 8; ++q) a[q] += w * f[q];
            S += blj; }
        *(LAS v4u*)(Cp + v * TS + ch * 16) = pack8(a); }
    if (tid < 128) { float a = 0.f, S = 0.f;
        for (int j = c - 1; j >= 0; --j) { const float ml = msc[2 * (bh * 16 + j)], blj = msc[2 * (bh * 16 + j) + 1]; a += expf(S + ml - mp) * nloc[(size_t)(bh * 16 + j) * 128 + tid]; S += blj; }
        npv[tid] = a; }
    __syncthreads();
    const int fr = lane & 15, Q = lane >> 4, t = 16 * wave + fr;
    const float Mt = fmaxf(mp, garr[256 + t]), eint = expf(mp - Mt), emt = expf(-garr[t] - Mt);
    bf16x8 qf[4];
#pragma unroll
    for (int kk = 0; kk < 4; ++kk) qf[kk] = *(const LAS bf16x8*)(Qs + t * TS + (32 * kk + 8 * Q) * 2);
    unsigned pk[8][2]; float den = 0.f;
#pragma unroll
    for (int st = 0; st < 8; ++st) {
        if (st <= wave) {
            f32x4 sa = (f32x4){0.f, 0.f, 0.f, 0.f};
#pragma unroll
            for (int kk = 0; kk < 4; ++kk) sa = mfma16(*(const LAS bf16x8*)(Ks + (16 * st + fr) * TS + (32 * kk + 8 * Q) * 2), qf[kk], sa);
            float p[4];
#pragma unroll
            for (int r = 0; r < 4; ++r) { const int s = 16 * st + 4 * Q + r; p[r] = (s <= t) ? sa[r] * expf(garr[128 + s] - Mt) : 0.f; den += p[r]; }
            pk[st][0] = cvtpk(p[0], p[1]); pk[st][1] = cvtpk(p[2], p[3]);
        } else { pk[st][0] = 0u; pk[st][1] = 0u; }
    }
    f32x4 a1[8], a2[8];
#pragma unroll
    for (int n = 0; n < 8; ++n) { a1[n] = (f32x4){0.f, 0.f, 0.f, 0.f}; a2[n] = (f32x4){0.f, 0.f, 0.f, 0.f}; }
#pragma unroll
    for (int kk = 0; kk < 4; ++kk) {
        if (2 * kk <= wave) { v4u w; w.x = pk[2 * kk][0]; w.y = pk[2 * kk][1]; w.z = pk[2 * kk + 1][0]; w.w = pk[2 * kk + 1][1]; const bf16x8 bfr = __builtin_bit_cast(bf16x8, w);
#pragma unroll
            for (int vt = 0; vt < 8; ++vt) a1[vt] = mfma16(tr_pair(Vs, TS, 32 * kk, 16 * vt, fr, Q), bfr, a1[vt]); }
    }
    float dint = 0.f;
#pragma unroll
    for (int kk = 0; kk < 4; ++kk) {
#pragma unroll
        for (int vt = 0; vt < 8; ++vt) a2[vt] = mfma16(*(const LAS bf16x8*)(Cp + (16 * vt + fr) * TS + (32 * kk + 8 * Q) * 2), qf[kk], a2[vt]);
        float f[8]; unpack8(__builtin_bit_cast(v4u, qf[kk]), f);
#pragma unroll
        for (int j = 0; j < 8; ++j) dint += npv[32 * kk + 8 * Q + j] * f[j];
    }
    den += __shfl_xor(den, 16); den += __shfl_xor(den, 32); dint += __shfl_xor(dint, 16); dint += __shfl_xor(dint, 32);
    const float dtot = den + eint * dint; const float rden = 1.f / fmaxf(fabsf(dtot), emt);
    float sum = 0.f;
#pragma unroll
    for (int vt = 0; vt < 8; ++vt)
#pragma unroll
        for (int r = 0; r < 4; ++r) { a1[vt][r] = (a1[vt][r] + eint * a2[vt][r]) * rden; sum += a1[vt][r]; }
    sum += __shfl_xor(sum, 16); sum += __shfl_xor(sum, 32);
    const float mu = sum * (1.f / 128.f); float sq = 0.f;
#pragma unroll
    for (int vt = 0; vt < 8; ++vt)
#pragma unroll
        for (int r = 0; r < 4; ++r) { const float d = a1[vt][r] - mu; sq += d * d; }
    sq += __shfl_xor(sq, 16); sq += __shfl_xor(sq, 32);
    const float rstd = 1.f / sqrtf(sq * (1.f / 128.f) + LN_EPS);
    const size_t tok = tok0 + t;
#pragma unroll
    for (int vt = 0; vt < 8; ++vt) { const int col = h * 128 + 16 * vt + 4 * Q; const size_t off = tok * 512 + col;
        const f32x4 ng = *(const f32x4*)(norm_g + col); const u32x2 o = *(const u32x2*)(CO + off), z = *(const u32x2*)(CZ + off);
        u32x2 w; w.x = cvtpk((a1[vt][0] - mu) * rstd * ng[0] * bflo(o.x) * bflo(z.x), (a1[vt][1] - mu) * rstd * ng[1] * bfhi(o.x) * bfhi(z.x));
        w.y = cvtpk((a1[vt][2] - mu) * rstd * ng[2] * bflo(o.y) * bflo(z.y), (a1[vt][3] - mu) * rstd * ng[3] * bfhi(o.y) * bfhi(z.y));
        *(u32x2*)(CZ + off) = w; }
    __syncthreads();
}
__device__ __forceinline__ void cmp_item(lds_t lds, int item, const bf16* KV, const float* posk, const float* posv, const bf16* w1t, const bf16* w2t, bf16* kcmp, bf16* vcmp,
                                         int tid, int lane, int wave) {
    const int nt = item & 7, kv = (item >> 3) & 1, g = (item >> 4) & 1, b = item >> 5;
    const int fr = lane & 15, Q = lane >> 4;
    const float* pos = kv ? posv : posk; const bf16* W1 = w1t + (size_t)kv * 128 * 2048; const bf16* W2 = w2t + (size_t)kv * 64 * 128;
    bf16* outp = (kv ? vcmp : kcmp) + (size_t)((b * 2 + g) * 128) * 64;
    const int n = 16 * nt + fr;
    const bf16* arow = KV + (size_t)b * T * 768 + kv * 128 + g * 64;
    const bf16* brow = W1 + (size_t)(16 * wave + fr) * 2048;
    f32x4 acc = (f32x4){0.f, 0.f, 0.f, 0.f};
#pragma unroll 4
    for (int ks = 0; ks < 64; ++ks) { const int l = ks >> 1, d0 = 32 * (ks & 1) + 8 * Q;
        int tk = 16 * n + l; tk = tk > T - 1 ? T - 1 : tk;
        const v4u x = *(const v4u*)(arow + (size_t)tk * 768 + d0); float f[8]; unpack8(x, f);
        const f32x4 p0 = *(const f32x4*)(pos + l * 64 + d0), p1 = *(const f32x4*)(pos + l * 64 + d0 + 4);
#pragma unroll
        for (int j = 0; j < 4; ++j) { f[j] += p0[j]; f[4 + j] += p1[j]; }
        const bf16x8 afr = __builtin_bit_cast(bf16x8, pack8(f));
        const bf16x8 bfr = *(const bf16x8*)(brow + 32 * ks + 8 * Q);
        acc = mfma16(afr, bfr, acc); }
#pragma unroll
    for (int r = 0; r < 4; ++r) { const unsigned hv = cvtpk(gelut(acc[r]), 0.f); *(LAS unsigned short*)(lds + (4 * Q + r) * 272 + (16 * wave + fr) * 2) = (unsigned short)(hv & 0xffffu); }
    __syncthreads();
    if (wave < 4) {
        f32x4 o = (f32x4){0.f, 0.f, 0.f, 0.f};
#pragma unroll
        for (int kk = 0; kk < 4; ++kk) { const bf16x8 afr = *(const LAS bf16x8*)(lds + fr * 272 + (32 * kk + 8 * Q) * 2);
            const bf16x8 bfr = *(const bf16x8*)(W2 + (size_t)(16 * wave + fr) * 128 + 32 * kk + 8 * Q);
            o = mfma16(afr, bfr, o); }
#pragma unroll
        for (int r = 0; r < 4; ++r) { const int nn = 16 * nt + 4 * Q + r; const float v = (nn < 127) ? o[r] : 0.f;
            outp[(size_t)nn * 64 + 16 * wave + fr] = (bf16)(cvtpk(v, 0.f) & 0xffffu); }
    }
    __syncthreads();
}

constexpr int VS = 160;
constexpr int NSA_WAVE_LDS = 64 * VS;
struct NsaCtx { int fr, Q, tq, t0, cur; unsigned selmask; lds_t wl; };
__device__ __forceinline__ void nsa_scores(f32x4 (&st)[4], const bf16x8 (&kf)[4][2], const bf16x8 (&q)[2]) {
#pragma unroll
    for (int kt = 0; kt < 4; ++kt) { st[kt] = mfma16(kf[kt][0], q[0], (f32x4){0.f, 0.f, 0.f, 0.f}); st[kt] = mfma16(kf[kt][1], q[1], st[kt]); }
}
template <int MODE> __device__ __forceinline__ bool nsa_valid(const NsaCtx& c, int key, int& dist) {
    if (MODE == 0) { dist = c.tq - (16 * key + 31); return dist >= 0; }
    dist = c.tq - key;
    if (MODE == 1) return dist >= 0;
    return dist >= 0 && dist < 256;
}
template <int MODE, int NHH> __device__ __forceinline__ void nsa_pass1(const NsaCtx& c, const bf16* Kb, int ld, int j_lo, int j_hi, const bf16x8 (&qf)[NHH][2], const float (&slope2)[NHH],
                                                                       float (&mrun)[NHH], float (&inv)[NHH]) {
    const int fr = c.fr, Q = c.Q;
    float lrun[NHH];
#pragma unroll
    for (int h = 0; h < NHH; ++h) { mrun[h] = -1e30f; lrun[h] = 0.f; }
#pragma unroll 1
    for (int j = j_lo; j <= j_hi; ++j) {
        if (MODE == 1) { if (!__any((int)((c.selmask >> j) & 1u))) continue; }
        const bool blk_ok = (MODE != 1) || ((c.selmask >> j) & 1u);
        const int key0 = 64 * j;
        bf16x8 kf[4][2];
#pragma unroll
        for (int kt = 0; kt < 4; ++kt)
#pragma unroll
            for (int ks = 0; ks < 2; ++ks) kf[kt][ks] = *(const bf16x8*)(Kb + (size_t)(key0 + 16 * kt + fr) * ld + 32 * ks + 8 * Q);
#pragma unroll
        for (int h = 0; h < NHH; ++h) { f32x4 st[4]; nsa_scores(st, kf, qf[h]);
            float sc[16]; float mx = -1e30f;
#pragma unroll
            for (int kt = 0; kt < 4; ++kt)
#pragma unroll
                for (int r = 0; r < 4; ++r) { int dist; const bool ok = nsa_valid<MODE>(c, key0 + 16 * kt + 4 * Q + r, dist) && blk_ok;
                    const float v = ok ? (st[kt][r] * L2E - slope2[h] * (float)dist) : -1e30f; sc[4 * kt + r] = v; mx = fmaxf(mx, v); }
            const float mn = fmaxf(mrun[h], mx); float s = 0.f;
#pragma unroll
            for (int i = 0; i < 16; ++i) s += (sc[i] > -1e29f) ? __builtin_amdgcn_exp2f(sc[i] - mn) : 0.f;
            lrun[h] = lrun[h] * __builtin_amdgcn_exp2f(mrun[h] - mn) + s; mrun[h] = mn; }
    }
#pragma unroll
    for (int h = 0; h < NHH; ++h) { float mt = fmaxf(mrun[h], __shfl_xor(mrun[h], 16)); mt = fmaxf(mt, __shfl_xor(mt, 32));
        float l = lrun[h] * __builtin_amdgcn_exp2f(mrun[h] - mt); l += __shfl_xor(l, 16); l += __shfl_xor(l, 32);
        mrun[h] = mt; inv[h] = 1.f / fmaxf(l, 1e-30f); }
}
template <int MODE, int NHH, bool IMP, bool PV> __device__ __forceinline__ void nsa_pass2(const NsaCtx& c, const bf16* Kb, const bf16* Vb, int ld, int j_lo, int j_hi, const bf16x8 (&qf)[NHH][2],
        const float (&slope2)[NHH], const float (&mrun)[NHH], const float (&inv)[NHH], const float (&gate)[NHH], f32x4 (&oacc)[NHH][4], float (&imp)[8], int lane) {
    const int fr = c.fr, Q = c.Q;
#pragma unroll 1
    for (int j = j_lo; j <= j_hi; ++j) {
        if (MODE == 1) { if (!__any((int)((c.selmask >> j) & 1u))) continue; }
        const bool blk_ok = (MODE != 1) || ((c.selmask >> j) & 1u);
        const int key0 = 64 * j;
        bf16x8 kf[4][2];
#pragma unroll
        for (int kt = 0; kt < 4; ++kt)
#pragma unroll
            for (int ks = 0; ks < 2; ++ks) kf[kt][ks] = *(const bf16x8*)(Kb + (size_t)(key0 + 16 * kt + fr) * ld + 32 * ks + 8 * Q);
        if (PV) {
            asm volatile("" ::: "memory");
#pragma unroll
            for (int i = 0; i < 8; ++i) { const int row = (lane >> 3) + 8 * i, cc = lane & 7;
                *(LAS v4u*)(c.wl + row * VS + cc * 16) = *(const v4u*)(Vb + (size_t)(key0 + row) * ld + 8 * cc); }
            asm volatile("s_waitcnt lgkmcnt(0)" ::: "memory");
        }
#pragma unroll
        for (int h = 0; h < NHH; ++h) { f32x4 st[4]; nsa_scores(st, kf, qf[h]);
            unsigned pk[4][2]; const float cf = inv[h] * gate[h];
#pragma unroll
            for (int kt = 0; kt < 4; ++kt) { float p[4];
#pragma unroll
                for (int r = 0; r < 4; ++r) { int dist; const bool ok = nsa_valid<MODE>(c, key0 + 16 * kt + 4 * Q + r, dist) && blk_ok;
                    p[r] = ok ? __builtin_amdgcn_exp2f(st[kt][r] * L2E - slope2[h] * (float)dist - mrun[h]) : 0.f; }
                if (IMP) {
                    const int Tt = 4 * j + kt; const float pn3 = p[3] * inv[h]; const float own = ((p[0] + p[1]) + (p[2] + p[3])) * inv[h];
                    const float recv = __shfl(pn3, (lane + 48) & 63);
#pragma unroll
                    for (int tt = 0; tt < 8; ++tt) { if (tt == Tt) imp[tt] += own + (Q > 0 ? recv : 0.f); if (tt == Tt + 1) imp[tt] += (Q == 0 ? recv : 0.f); }
                }
                if (PV) { pk[kt][0] = cvtpk(p[0] * cf, p[1] * cf); pk[kt][1] = cvtpk(p[2] * cf, p[3] * cf); } }
            if (PV) {
#pragma unroll
                for (int kk = 0; kk < 2; ++kk) { v4u w; w.x = pk[2 * kk][0]; w.y = pk[2 * kk][1]; w.z = pk[2 * kk + 1][0]; w.w = pk[2 * kk + 1][1]; const bf16x8 bfr = __builtin_bit_cast(bf16x8, w);
#pragma unroll
                    for (int dt = 0; dt < 4; ++dt) oacc[h][dt] = mfma16(tr_pair(c.wl, VS, 32 * kk, 16 * dt, fr, Q), bfr, oacc[h][dt]); }
            }
        }
        if (PV) asm volatile("s_waitcnt lgkmcnt(0)" ::: "memory");
    }
}
__device__ __forceinline__ void nsa_unit(lds_t wl, int b, int g, int qt, const bf16* AQ, const bf16* KV, bf16* AZ, const float* narrow, const bf16* kcmp, const bf16* vcmp, int lane) {
    NsaCtx c; c.fr = lane & 15; c.Q = lane >> 4; c.t0 = 16 * qt; c.tq = c.t0 + c.fr; c.cur = c.t0 >> 6; c.selmask = 0u; c.wl = wl;
    const size_t tokq = (size_t)b * T + c.tq;
    const bf16* kvb = KV + (size_t)b * T * 768 + g * 64;
    const bf16* kcb = kcmp + (size_t)((b * 2 + g) * 128) * 64; const bf16* vcb = vcmp + (size_t)((b * 2 + g) * 128) * 64;
    const int cmp_hi = (c.t0 >= 16) ? (((c.t0 - 16) >> 4) >> 6) : -1;
    const float* gp = narrow + tokq * 32 + g * 4;
    float imp[8];
#pragma unroll
    for (int i = 0; i < 8; ++i) imp[i] = 0.f;
    if (c.cur <= 7) c.selmask = (2u << c.cur) - 1u;
    else {
#pragma unroll 1
        for (int hp = 0; hp < 2; ++hp) {
            const int h0 = 2 * hp;
            bf16x8 qf[2][2]; float slope2[2], mrun[2], inv[2], gate[2]; f32x4 odummy[2][4];
#pragma unroll
            for (int h = 0; h < 2; ++h) { slope2[h] = ldexpf(L2E, -(g * 4 + h0 + h + 1)); gate[h] = 0.f;
#pragma unroll
                for (int ks = 0; ks < 2; ++ks) qf[h][ks] = *(const bf16x8*)(AQ + tokq * 512 + g * 256 + (h0 + h) * 64 + 32 * ks + 8 * c.Q); }
            nsa_pass1<0, 2>(c, kcb, 64, 0, cmp_hi, qf, slope2, mrun, inv);
            nsa_pass2<0, 2, true, false>(c, kcb, vcb, 64, 0, cmp_hi, qf, slope2, mrun, inv, gate, odummy, imp, lane);
        }
        unsigned sel = 1u | (1u << c.cur) | (1u << (c.cur - 1));
        float cand[8];
#pragma unroll
        for (int tt = 0; tt < 8; ++tt) { const int jb = 4 * tt + c.Q; cand[tt] = (jb > 0 && jb < c.cur - 1) ? imp[tt] : -1.f; }
#pragma unroll 1
        for (int it = 0; it < 5; ++it) {
            float bv = cand[0]; int bj = c.Q;
#pragma unroll
            for (int tt = 1; tt < 8; ++tt) if (cand[tt] > bv) { bv = cand[tt]; bj = 4 * tt + c.Q; }
#pragma unroll
            for (int off = 16; off <= 32; off <<= 1) { const float ov = __shfl_xor(bv, off); const int oj = __shfl_xor(bj, off); if (ov > bv || (ov == bv && oj < bj)) { bv = ov; bj = oj; } }
            sel |= 1u << bj;
#pragma unroll
            for (int tt = 0; tt < 8; ++tt) if (4 * tt + c.Q == bj) cand[tt] = -1.f;
        }
        c.selmask = sel;
    }
#pragma unroll 1
    for (int hp = 0; hp < 2; ++hp) {
        const int h0 = 2 * hp;
        bf16x8 qf[2][2]; float slope2[2], mrun[2], inv[2], gate[2]; f32x4 oacc[2][4];
#pragma unroll
        for (int h = 0; h < 2; ++h) { slope2[h] = ldexpf(L2E, -(g * 4 + h0 + h + 1));
#pragma unroll
            for (int ks = 0; ks < 2; ++ks) qf[h][ks] = *(const bf16x8*)(AQ + tokq * 512 + g * 256 + (h0 + h) * 64 + 32 * ks + 8 * c.Q);
#pragma unroll
            for (int dt = 0; dt < 4; ++dt) oacc[h][dt] = (f32x4){0.f, 0.f, 0.f, 0.f}; }
        if (cmp_hi >= 0) {
            gate[0] = gp[h0]; gate[1] = gp[h0 + 1];
            nsa_pass1<0, 2>(c, kcb, 64, 0, cmp_hi, qf, slope2, mrun, inv);
            nsa_pass2<0, 2, false, true>(c, kcb, vcb, 64, 0, cmp_hi, qf, slope2, mrun, inv, gate, oacc, imp, lane);
        }
        gate[0] = gp[8 + h0]; gate[1] = gp[8 + h0 + 1];
        nsa_pass1<1, 2>(c, kvb + 256, 768, 0, c.cur, qf, slope2, mrun, inv);
        nsa_pass2<1, 2, false, true>(c, kvb + 256, kvb + 384, 768, 0, c.cur, qf, slope2, mrun, inv, gate, oacc, imp, lane);
        gate[0] = gp[16 + h0]; gate[1] = gp[16 + h0 + 1];
        { const int lo = c.t0 - 255, jl = (lo > 0 ? lo : 0) >> 6;
          nsa_pass1<2, 2>(c, kvb + 512, 768, jl, c.cur, qf, slope2, mrun, inv);
          nsa_pass2<2, 2, false, true>(c, kvb + 512, kvb + 640, 768, jl, c.cur, qf, slope2, mrun, inv, gate, oacc, imp, lane); }
#pragma unroll
        for (int h = 0; h < 2; ++h)
#pragma unroll
            for (int dt = 0; dt < 4; ++dt) { const size_t off = tokq * 512 + g * 256 + (h0 + h) * 64 + 16 * dt + 4 * c.Q; const u32x2 z = *(const u32x2*)(AZ + off);
                u32x2 w; w.x = cvtpk(oacc[h][dt][0] * bflo(z.x), oacc[h][dt][1] * bfhi(z.x)); w.y = cvtpk(oacc[h][dt][2] * bflo(z.y), oacc[h][dt][3] * bfhi(z.y));
                *(u32x2*)(AZ + off) = w; }
    }
}
#ifndef PHSEL
#define PHSEL -1
#endif
#define PHEN(k) (PHSEL < 0 || PHSEL == (k))
#ifndef DBG_SKIP_GMLP
#define DBG_SKIP_GMLP 0
#endif
#ifndef DBG_SKIPMASK
#define DBG_SKIPMASK 0
#endif
#ifndef DBG_NPH
#define DBG_NPH NPHASE
#endif
#define INP(k) ld_ptr(ptab, (k))
struct OneUnit { pg8::Unit u;
    __device__ __forceinline__ bool next(int i, pg8::Unit& o) const { if (i != 0) return false; o = u; return true; }
    __device__ __forceinline__ void a_ready(const pg8::Unit&) const {}
    __device__ __forceinline__ void done(const pg8::Unit&) const {} };
struct Args { const float* in[26]; float* out; unsigned char* ws; int ph_lo, ph_hi; };
static_assert(sizeof(Args) == 26 * 8 + 8 + 8 + 8, "Args has no padding");

__global__ void __launch_bounds__(512, 2) mk_fwd(Args args) {
    extern __shared__ __attribute__((aligned(16))) unsigned char lds_raw[];
    lds_t lds = (lds_t)lds_raw;
    const int tid0 = threadIdx.x;
    const int G0_ = gridDim.x; const int bx0_ = blockIdx.x;
    volatile LAS unsigned* MISC = (volatile LAS unsigned*)(lds + MISC_OFF);
    if (tid0 < 32) MISC[tid0] = 0u;
    LAS unsigned long long* ptab = (LAS unsigned long long*)(lds + MISC_OFF + 256);
    if (tid0 == 0) {
#pragma unroll
        for (int i = 0; i < 26; ++i) ptab[i] = (unsigned long long)(uintptr_t)args.in[i];
    }
    __syncthreads();
    unsigned char* ws0 = args.ws; float* out = args.out;
    gu32* ctl = (gu32*)(ws0 + WS_CTL);
    XcdBarrier bar; bar.bar = (unsigned*)(ctl + CW_BAR); bar.x = 0; bar.st = nullptr;
#if !MK_PER_PHASE
    bar = xcd_barrier_post((unsigned*)(ctl + CW_BAR), MISC + 8);
#endif
    for (int ph = args.ph_lo; ph < args.ph_hi; ++ph) {
        const int L = ph == 0 ? 0 : (ph - 1) >> 3, sub = ph == 0 ? -1 : (ph - 1) & 7;
        int tid = tid0; asm volatile("" : "+v"(tid));
        const int lane = tid & 63, wave = __builtin_amdgcn_readfirstlane(tid >> 6);
        int G = G0_, bx = bx0_; asm volatile("" : "+s"(G), "+s"(bx));
        const int vcu = (G % 8 == 0) ? (bx % 8) * (G / 8) + bx / 8 : bx;
        GAS unsigned char* wsg = (GAS unsigned char*)ws0; asm volatile("" : "+s"(wsg)); unsigned char* ws = (unsigned char*)wsg;
        unsigned char* proj = ws + WS_PROJ;
        bf16* XB = (bf16*)(ws + WS_XB); bf16* PBb = (bf16*)(ws + WS_PB); float* narrow = (float*)(ws + WS_NARROW);
        bf16* WIN = (bf16*)(ws + WS_WIN);
        bf16* AQ = (bf16*)(proj + F_AQ); bf16* KV = (bf16*)(proj + F_KV); bf16* AZ = (bf16*)(proj + F_AZ); bf16* BU = (bf16*)(proj + F_BU); bf16* BV = (bf16*)(proj + F_BV);
        bf16* BZ = (bf16*)(proj + F_BZ); bf16* CQ = (bf16*)(proj + F_CQ); bf16* CK = (bf16*)(proj + F_CK); bf16* CV = (bf16*)(proj + F_CV); bf16* CO = (bf16*)(proj + F_CO);
        bf16* CZ = (bf16*)(proj + F_CZ);
        bf16* G0 = (bf16*)(proj + S1); bf16* G1 = (bf16*)(proj + S2); bf16* G2 = (bf16*)(proj + S3); bf16* MG = (bf16*)(proj + S4); bf16* PW = (bf16*)(proj + S1);
        bf16* kcmp = (bf16*)(ws + WS_KCMP); bf16* vcmp = (bf16*)(ws + WS_VCMP); bf16* cloc = (bf16*)(ws + WS_CLOC); float* nloc = (float*)(ws + WS_NLOC); float* msc = (float*)(ws + WS_MSC);

        if (ph >= NPHASE || ((DBG_SKIPMASK >> ph) & 1)) {
        } else if (ph == 0 && PHEN(0)) {
            cvt_rows(INP(0), XB, (size_t)M * DM / 8, (size_t)vcu * 512 + tid, (size_t)G * 512);
        } else if (sub == 0 && PHEN(1)) {
            pg8::Gemm g{XB, WIN, M, 6144, 1024}; pg8::StaticOrder S; S.init(M, 6144, G, bx);
            pg8::EpiProj E{proj, narrow};
            pg8::gemm_phase<pg8::EpiProj, pg8::StaticOrder, true, true>(lds, g, S, E);
        } else if (sub == 1 && PHEN(2)) {
            const float* cw = INP(13) + (size_t)L * 4 * 1024; const float* cb = INP(14) + (size_t)L * 1024;
            for (int it = bx; it < 256 + 512 + 512; it += G) {
                if (it < 256) cmp_item(lds, it, KV, INP(3) + (size_t)L * 32 * 64, INP(4) + (size_t)L * 32 * 64, (const bf16*)(ws + WS_CW1), (const bf16*)(ws + WS_CW2), kcmp, vcmp, tid, lane, wave);
                else if (it < 768) mlstm1_item(lds, it - 256, CK, CV, narrow, cw, cb, INP(15) + L * 4, INP(16) + L * 4, cloc, nloc, msc, tid, lane, wave);
                else if (!DBG_SKIP_GMLP) gmlp_item(lds, it - 768, BU, BV, BZ, INP(9) + (size_t)L * 512, INP(10) + (size_t)L * 512, (const bf16*)(ws + WS_SGW), INP(12) + (size_t)L * 512, tid, lane, wave);
            }
        } else if (sub == 2 && PHEN(3)) {
            const float* cw = INP(13) + (size_t)L * 4 * 1024; const float* cb = INP(14) + (size_t)L * 1024;
#ifndef DBG_NO_ML3
            for (int it = bx; it < 512; it += G)
                mlstm3_item(lds, it, CQ, CK, CV, CO, CZ, narrow, cw, cb, INP(15) + L * 4, INP(16) + L * 4, INP(17) + (size_t)L * 512, cloc, nloc, msc, tid, lane, wave);
#endif
            __syncthreads();
#ifndef DBG_NO_NSA
            for (int k = 0;; ++k) { const int rho = bx + G * (wave + 8 * k); if (rho >= 2048) break;
                const int qt = 127 - (rho >> 4), bg = rho & 15;
                int lane_u = lane; asm volatile("" : "+v"(lane_u));
                nsa_unit(lds + wave * NSA_WAVE_LDS, bg >> 1, bg & 1, qt, AQ, KV, AZ, narrow, kcmp, vcmp, lane_u); }
#endif
        } else if (sub == 3 && PHEN(4)) {
            pg8::Gemm g{XB, WIN + (size_t)6144 * 1024, M, 3072, 1024}; pg8::StaticOrder S; S.init(M, 3072, G, bx);
            pg8::EpiGate E{proj};
            pg8::gemm_phase<pg8::EpiGate, pg8::StaticOrder, true, true>(lds, g, S, E);
        } else if (sub == 4 && PHEN(5)) {
            bf16* WBR = (bf16*)(ws + WS_WBR); pg8::StaticOrder S; S.init(M, 1024, G, bx);
            { pg8::Gemm g{AZ, WBR, M, 1024, 512}; pg8::EpiBranch<true> E{G0, MG, ABL_A}; pg8::gemm_phase<pg8::EpiBranch<true>, pg8::StaticOrder, false, true>(lds, g, S, E); }
            { pg8::Gemm g{BU, WBR + 1024 * 512, M, 1024, 512}; pg8::EpiBranch<false> E{G1, MG, ABL_B}; pg8::gemm_phase<pg8::EpiBranch<false>, pg8::StaticOrder, false, true>(lds, g, S, E); }
            { pg8::Gemm g{CZ, WBR + 2 * 1024 * 512, M, 1024, 512}; pg8::EpiBranch<false> E{G2, MG, ABL_C}; pg8::gemm_phase<pg8::EpiBranch<false>, pg8::StaticOrder, false, true>(lds, g, S, E); }
        } else if (sub == 5 && PHEN(6)) {
            pg8::StaticOrder S; S.init(M, 1024, G, bx);
            { pg8::Gemm g{MG, (const bf16*)(ws + WS_WOUT), M, 1024, 1024}; pg8::EpiOut E{L == 0 ? INP(0) : (const float*)out, out, XB, ALPHA};
              pg8::gemm_phase<pg8::EpiOut, pg8::StaticOrder, false, true>(lds, g, S, E); }
            { pg8::Gemm g{PBb, (const bf16*)(ws + WS_WPW), M, 1024, 256}; pg8::EpiPw E{PW}; pg8::gemm_phase<pg8::EpiPw, pg8::StaticOrder, false, true>(lds, g, S, E); }
        } else if (sub == 6 && PHEN(7)) {
            pg8::StaticOrder S; S.init(M, 1024, G, bx);
            pg8::Gemm g{XB, (const bf16*)(ws + WS_WPG), M, 1024, 1024}; pg8::EpiPle E{out, PW};
            pg8::gemm_phase<pg8::EpiPle, pg8::StaticOrder, false, true>(lds, g, S, E);
        } else if (PHEN(8)) {
            const float* lg = INP(24) + (size_t)L * 1024; const float* lb = INP(25) + (size_t)L * 1024;
            for (int m = vcu * 8 + wave; m < M; m += G * 8) ln_row(out + (size_t)m * DM, out + (size_t)m * DM, XB + (size_t)m * DM, lg, lb, lane);
        }
        if ((ph == 0 || ph == 8) && PHEN(0)) {
            int Lv = ph == 0 ? 0 : 1; asm volatile("" : "+v"(Lv)); const int Lc = __builtin_amdgcn_readfirstlane(Lv);
            conv_layer(ptab, ws, Lc, lds, vcu, G, tid, lane, wave);
        }
#ifdef DBG_DUMP_OFF
        if (ph == 100) {
            const bf16* src = (const bf16*)(ws + DBG_DUMP_OFF);
            for (size_t i = (size_t)bx * 512 + tid; i < (size_t)M * DM; i += (size_t)G * 512) out[i] = __uint_as_float((unsigned)src[i] << 16);
        }
#endif
#if !MK_PER_PHASE
        if (ph + 1 < args.ph_hi) { XcdBarrier b2 = bar; asm volatile("" : "+s"(b2.bar), "+s"(b2.x)); xcd_barrier(b2); }
#endif
    }
}

__global__ void fill_const(float* out, int n, float v) { for (int i = blockIdx.x * blockDim.x + threadIdx.x; i < n; i += gridDim.x * blockDim.x) out[i] = v; }

extern "C" void kernel_launch(void* const* d_in, const int* in_sizes, int n_in, void* d_out, int out_size, void* d_ws, size_t ws_size, hipStream_t stream) {
    static int grid = 0;
    if (grid == 0) {
        int dev = 0, cus = 0, per_cu = 0;
        if (n_in != 26 || out_size != M * DM || ws_size < WS_END) { fprintf(stderr, "kernel_launch: unexpected shapes (n_in %d out %d ws %zu, need %zu)\n", n_in, out_size, ws_size, (size_t)WS_END); grid = -1; }
        else if (hipGetDevice(&dev) != hipSuccess || hipDeviceGetAttribute(&cus, hipDeviceAttributeMultiprocessorCount, dev) != hipSuccess) grid = -1;
        else if (hipFuncSetAttribute((const void*)mk_fwd, hipFuncAttributeMaxDynamicSharedMemorySize, LDS_BYTES) != hipSuccess) grid = -1;
        else {
            if (hipOccupancyMaxActiveBlocksPerMultiprocessor(&per_cu, (const void*)mk_fwd, 512, LDS_BYTES) != hipSuccess || per_cu < 1) { fprintf(stderr, "kernel_launch: occupancy query says %d blocks per CU\n", per_cu); per_cu = 0; }
            (void)hipGetLastError();
            grid = per_cu >= 1 ? cus : -1;
        }
    }
    if (grid < 0) {
        hipLaunchKernelGGL(fill_const, dim3(1024), dim3(256), 0, stream, (float*)d_out, out_size, (float)((double)ws_size / 1.0e8));
        return;
    }
    (void)hipMemsetAsync((char*)d_ws + WS_CTL, 0, CTL_ZERO_BYTES, stream);
    Args a{};
    for (int i = 0; i < 26; ++i) a.in[i] = (const float*)d_in[i];
    a.out = (float*)d_out; a.ws = (unsigned char*)d_ws;
#if MK_PER_PHASE
    for (int ph = 0; ph < DBG_NPH; ++ph) { a.ph_lo = ph; a.ph_hi = ph + 1; hipLaunchKernelGGL(mk_fwd, dim3(grid), dim3(512), LDS_BYTES, stream, a); }
#ifdef DBG_DUMP_OFF
    a.ph_lo = 100; a.ph_hi = 101; hipLaunchKernelGGL(mk_fwd, dim3(grid), dim3(512), LDS_BYTES, stream, a);
#endif
#else
    a.ph_lo = 0; a.ph_hi = NPHASE;
    void* kargs[] = {&a};
    const hipError_t e = hipLaunchCooperativeKernel((const void*)mk_fwd, dim3(grid), dim3(512), kargs, LDS_BYTES, stream);
    if (e != hipSuccess) fprintf(stderr, "kernel_launch: cooperative launch failed: %s (grid %d)\n", hipGetErrorString(e), grid);
#endif
}
```

```cpp
#include <hip/hip_runtime.h>
#include <cstdio>
#include <cstdint>

#ifndef MK_PER_PHASE
#define MK_PER_PHASE 0
#endif
#ifndef ABL_A
#define ABL_A 1.0f
#endif
#ifndef ABL_B
#define ABL_B 1.0f
#endif
#ifndef ABL_C
#define ABL_C 1.0f
#endif
#define DUP_MASK 0
constexpr int NB = 8, T = 2048, DM = 1024, M = NB * T, DEPTH = 2, NIN = 8992, PLE = 256;
constexpr float ALPHA = 1.4142135623730951f;
constexpr float LN_EPS = 1e-5f;
constexpr float L2E = 1.4426950408889634f;
constexpr size_t MiB = 1u << 20, KiB = 1u << 10;
constexpr size_t WS_CTL = 0, CTL_ZERO_BYTES = 1 * MiB;
constexpr size_t WS_WIN = 1 * MiB;
constexpr size_t WS_WBR = WS_WIN + 18 * MiB;
constexpr size_t WS_WOUT = WS_WBR + 3 * MiB;
constexpr size_t WS_WPG = WS_WOUT + 2 * MiB;
constexpr size_t WS_WPW = WS_WPG + 2 * MiB;
constexpr size_t WS_CW1 = WS_WPW + 512 * KiB;
constexpr size_t WS_CW2 = WS_CW1 + 1 * MiB;
constexpr size_t WS_SGW = WS_CW2 + 32 * KiB;
constexpr size_t WS_KCMP = WS_SGW + 128 * KiB;
constexpr size_t WS_VCMP = WS_KCMP + 256 * KiB;
constexpr size_t WS_NLOC = WS_VCMP + 256 * KiB;
constexpr size_t WS_MSC = WS_NLOC + 256 * KiB;
constexpr size_t WS_XB = 29 * MiB;
static_assert(WS_MSC + 64 * KiB <= WS_XB, "ws map");
constexpr size_t WS_PB = WS_XB + 32 * MiB;
constexpr size_t WS_NARROW = WS_PB + 8 * MiB;
constexpr size_t WS_CLOC = WS_NARROW + 2 * MiB;
constexpr size_t WS_PROJ = WS_CLOC + 16 * MiB;
constexpr size_t WS_END = WS_PROJ + 184 * MiB;
constexpr size_t F_AZ = 0, F_BU = 16 * MiB, F_BV = 32 * MiB, F_BZ = 48 * MiB, F_CQ = 64 * MiB, F_CK = 80 * MiB,
                 F_CV = 96 * MiB, F_CO = 112 * MiB, F_CZ = 128 * MiB, F_AQ = 144 * MiB, F_KV = 160 * MiB;
constexpr size_t S1 = F_AQ, S2 = F_BV, S3 = F_CQ, S4 = F_CV;
constexpr int CW_BAR = 4096;
constexpr int RING_BYTES = 131072, MISC_OFF = 153600, LDS_BYTES = 154624;
constexpr int NPHASE = 17;
namespace pg8 {
#define PG8_LAS __attribute__((address_space(3)))
typedef unsigned short bf16_t;
typedef short bf16x8 __attribute__((ext_vector_type(8)));
typedef float f32x4 __attribute__((ext_vector_type(4)));
typedef unsigned u32x4 __attribute__((ext_vector_type(4)));
constexpr int BM = 256, BK = 64, HALF = 128, HTB = HALF * BK * 2  , STAGE_BYTES = 8 * HTB, NXCD = 8, WGM = 8;

__host__ __device__ __forceinline__ int lds_byte(int r, int c) { const int st = (r >> 4) * 2 + (c >> 5), rr = r & 15, cc = c & 31, ob = rr * 64 + cc * 2; return st * 1024 + (ob ^ (((ob >> 9) & 1) << 5)); }
__host__ __device__ __forceinline__ void stage_rc(int b, int& R, int& C) { const int st = b / 1024, sb = b % 1024, swz = sb ^ (((sb >> 9) & 1) << 5); R = (st >> 1) * 16 + swz / 64; C = (st & 1) * 32 + (swz % 64) / 2; }
__host__ __device__ __forceinline__ int perm32(int rho) { const int n = rho >> 4, i = rho & 15; return 8 * (i >> 2) + 4 * n + (i & 3); }

struct Unit { int pm, pn; };
struct Gemm { const bf16_t* A; const bf16_t* Bt; int M, N, K; };

struct StaticOrder {
    int nM, nN, nwg, G, c;
    __host__ __device__ void init(int M, int N, int G_, int c_) { nM = M / BM; nN = N / BM; nwg = nM * nN; G = G_; c = c_; }
    __host__ __device__ bool next(int i, Unit& u) const {
        const long L = (long)i * G + c; if (L >= nwg) return false;
        int wgid = (int)L; { const int q = nwg / NXCD, r = nwg % NXCD, xcd = wgid % NXCD, off = wgid / NXCD; wgid = (xcd < r ? xcd * (q + 1) : r * (q + 1) + (xcd - r) * q) + off; }
        const int nig = WGM * nN, gid = wgid / nig, fm = gid * WGM, gsz = (nM - fm) < WGM ? (nM - fm) : WGM;
        u.pm = fm + ((wgid % nig) % gsz); u.pn = (wgid % nig) / gsz; return true;
    }
    __device__ __forceinline__ void a_ready(const Unit&) const {}
    __device__ __forceinline__ void done(const Unit&) const {}
};

__device__ __forceinline__ unsigned cvt_pk_bf16(float lo, float hi) { unsigned r; asm volatile("v_cvt_pk_bf16_f32 %0, %1, %2" : "=v"(r) : "v"(lo), "v"(hi)); return r; }
typedef float f32x2 __attribute__((ext_vector_type(2)));
template <class Epi, class Sched, bool ALIGN_EPI = false, bool SP2 = false>
__device__ __forceinline__ void gemm_phase(PG8_LAS unsigned char* lds, const Gemm g, const Sched& S, const Epi& E) {
    int tid_l = threadIdx.x; asm volatile("" : "+v"(tid_l));
    const int tid = tid_l, wid = __builtin_amdgcn_readfirstlane(tid >> 6), lane = tid & 63, wr = wid >> 2, wc = wid & 3, fr = lane & 15, fq = lane >> 4;
    const int K = g.K, nt = K / BK;
    unsigned voffA[2], voffB[2];
#pragma unroll
    for (int i = 0; i < 2; ++i) { int R, C; stage_rc(tid * 16 + i * 8192, R, C); const int Rb = Epi::PERM ? ((R & ~31) + perm32(R & 31)) : R;
        voffA[i] = (unsigned)(R * K + C) * 2u; voffB[i] = (unsigned)(Rb * K + C) * 2u; }
    const size_t kstep = (size_t)(BK * 2);
    const size_t hstep = (size_t)HALF * K * 2;
    const size_t tstep = 2 * hstep;
    const unsigned ldsw = (unsigned)wid * 1024u;
    const int aoff = lds_byte(wr * 64 + fr, fq * 8), boff = lds_byte(wc * 32 + fr, fq * 8);
#define PG8_SA(b, h) (((b) * 2 + (h)) * HTB)
#define PG8_SB(b, h) ((4 + (b) * 2 + (h)) * HTB)
#define PG8_STAGE(bufoff, gbase, voff) do { _Pragma("unroll") for (int _i = 0; _i < 2; ++_i) \
        __builtin_amdgcn_global_load_lds((const unsigned*)((const char*)(gbase) + (voff)[_i]), (PG8_LAS unsigned*)(lds + (bufoff) + ldsw + _i * 8192), 16, 0, 0); } while (0)
#define PG8_LDA(dst, b, h) do { _Pragma("unroll") for (int m = 0; m < 4; ++m) _Pragma("unroll") for (int k = 0; k < 2; ++k) dst[m][k] = *(const PG8_LAS bf16x8*)(lds + PG8_SA(b, h) + aoff + m * 2048 + k * 1024); } while (0)
#define PG8_LDB(dst, b, h) do { _Pragma("unroll") for (int n = 0; n < 2; ++n) _Pragma("unroll") for (int k = 0; k < 2; ++k) dst[n][k] = *(const PG8_LAS bf16x8*)(lds + PG8_SB(b, h) + boff + n * 2048 + k * 1024); } while (0)
#define PG8_MMA(ai, bj, At, Bt) do { __builtin_amdgcn_s_setprio(1); _Pragma("unroll") for (int m = 0; m < 4; ++m) _Pragma("unroll") for (int n = 0; n < 2; ++n) _Pragma("unroll") for (int k = 0; k < 2; ++k) \
        acc[ai][bj][m][n] = __builtin_amdgcn_mfma_f32_16x16x32_bf16(Bt[n][k], At[m][k], acc[ai][bj][m][n], 0, 0, 0); __builtin_amdgcn_s_setprio(0); } while (0)
#define PG8_WAIT_V(n) asm volatile("s_waitcnt vmcnt(" #n ")" ::: "memory")
#define PG8_WAIT_L(n) asm volatile("s_waitcnt lgkmcnt(" #n ")" ::: "memory")
#define PG8_BAR __builtin_amdgcn_s_barrier()
#define PG8_SCHED __builtin_amdgcn_sched_barrier(0)
    Unit cur, nxt; int ui = 0;
    if (!S.next(0, cur)) return;
    f32x4 acc[2][2][4][2];
#pragma unroll
    for (int a = 0; a < 2; ++a)
#pragma unroll
        for (int b = 0; b < 2; ++b)
#pragma unroll
            for (int m = 0; m < 4; ++m)
#pragma unroll
                for (int n = 0; n < 2; ++n) acc[a][b][m][n] = (f32x4){0.f, 0.f, 0.f, 0.f};
    bf16x8 At[4][2], B0[2][2], B1[2][2];
    const char* cA = (const char*)g.A + (size_t)cur.pm * tstep; const char* cB = (const char*)g.Bt + (size_t)cur.pn * tstep;
    S.a_ready(cur);
    if constexpr (SP2) {
        PG8_STAGE(PG8_SB(0, 0), cB, voffB); PG8_STAGE(PG8_SB(0, 1), cB + hstep, voffB); PG8_STAGE(PG8_SA(0, 0), cA, voffA); PG8_STAGE(PG8_SA(0, 1), cA + hstep, voffA);
        if (wr == 1) PG8_BAR;
        PG8_WAIT_V(2); PG8_BAR;
        PG8_STAGE(PG8_SB(1, 0), cB + kstep, voffB); PG8_STAGE(PG8_SA(1, 0), cA + kstep, voffA); PG8_STAGE(PG8_SB(1, 1), cB + hstep + kstep, voffB);
        PG8_WAIT_V(6); PG8_BAR;
    } else {
        PG8_STAGE(PG8_SB(0, 0), cB, voffB); PG8_STAGE(PG8_SA(0, 0), cA, voffA); PG8_STAGE(PG8_SB(0, 1), cB + hstep, voffB); PG8_STAGE(PG8_SA(0, 1), cA + hstep, voffA);
        if (wr == 1) PG8_BAR;
        PG8_WAIT_V(4); PG8_BAR;
        PG8_STAGE(PG8_SB(1, 0), cB + kstep, voffB); PG8_STAGE(PG8_SA(1, 0), cA + kstep, voffA); PG8_STAGE(PG8_SB(1, 1), cB + hstep + kstep, voffB);
        PG8_WAIT_V(6); PG8_BAR;
    }
    for (;;) {
        const bool has_next = S.next(ui + 1, nxt);
        const char* nA = has_next ? (const char*)g.A + (size_t)nxt.pm * tstep : cA; const char* nB = has_next ? (const char*)g.Bt + (size_t)nxt.pn * tstep : cB;
        for (int t = 0; t < nt; t += 2) {
            const bool last = (t == nt - 2);
            const char* a1 = cA + (size_t)(t + 1) * kstep;
            const char* a2 = last ? nA : cA + (size_t)(t + 2) * kstep; const char* b2 = last ? nB : cB + (size_t)(t + 2) * kstep;
            const char* a3 = a2 + kstep; const char* b3 = b2 + kstep;
            if (last && has_next) S.a_ready(nxt);
            if constexpr (SP2) {
            PG8_LDB(B0, 0, 0); PG8_LDB(B1, 0, 1); PG8_SCHED; PG8_LDA(At, 0, 0); PG8_STAGE(PG8_SA(1, 1), a1 + hstep, voffA);
            PG8_WAIT_V(8); PG8_WAIT_L(0); PG8_BAR; PG8_MMA(0, 0, At, B0); PG8_MMA(0, 1, At, B1); PG8_BAR; PG8_SCHED;
            PG8_LDA(At, 0, 1); PG8_STAGE(PG8_SB(0, 0), b2, voffB); PG8_STAGE(PG8_SB(0, 1), b2 + hstep, voffB); PG8_STAGE(PG8_SA(0, 0), a2, voffA);
            PG8_WAIT_V(8); PG8_WAIT_L(0); PG8_BAR; PG8_MMA(1, 0, At, B0); PG8_MMA(1, 1, At, B1); PG8_BAR; PG8_SCHED;
            PG8_LDB(B0, 1, 0); PG8_LDB(B1, 1, 1); PG8_SCHED; PG8_LDA(At, 1, 0); PG8_STAGE(PG8_SA(0, 1), a2 + hstep, voffA);
            PG8_WAIT_V(8); PG8_WAIT_L(0); PG8_BAR; PG8_MMA(0, 0, At, B0); PG8_MMA(0, 1, At, B1); PG8_BAR; PG8_SCHED;
            PG8_LDA(At, 1, 1); PG8_STAGE(PG8_SB(1, 0), b3, voffB); PG8_STAGE(PG8_SB(1, 1), b3 + hstep, voffB); PG8_STAGE(PG8_SA(1, 0), a3, voffA);
            PG8_WAIT_V(8); PG8_WAIT_L(0); PG8_BAR; PG8_MMA(1, 0, At, B0); PG8_MMA(1, 1, At, B1); PG8_BAR; PG8_SCHED;
            } else {
            PG8_LDB(B0, 0, 0); PG8_SCHED; PG8_LDA(At, 0, 0); PG8_STAGE(PG8_SA(1, 1), a1 + hstep, voffA);
            PG8_WAIT_L(8); PG8_BAR; PG8_WAIT_L(0); PG8_MMA(0, 0, At, B0); PG8_BAR; PG8_SCHED;
            PG8_LDB(B1, 0, 1); PG8_STAGE(PG8_SB(0, 0), b2, voffB);
            PG8_BAR; PG8_WAIT_L(0); PG8_MMA(0, 1, At, B1); PG8_BAR;
            PG8_LDA(At, 0, 1); PG8_STAGE(PG8_SA(0, 0), a2, voffA);
            PG8_BAR; PG8_WAIT_L(0); PG8_MMA(1, 0, At, B0); PG8_BAR; PG8_SCHED;
            PG8_STAGE(PG8_SB(0, 1), b2 + hstep, voffB);
            PG8_WAIT_V(6); PG8_BAR; PG8_MMA(1, 1, At, B1); PG8_BAR;
            PG8_LDB(B0, 1, 0); PG8_SCHED; PG8_LDA(At, 1, 0); PG8_STAGE(PG8_SA(0, 1), a2 + hstep, voffA);
            PG8_WAIT_L(8); PG8_BAR; PG8_WAIT_L(0); PG8_MMA(0, 0, At, B0); PG8_BAR; PG8_SCHED;
            PG8_LDB(B1, 1, 1); PG8_STAGE(PG8_SB(1, 0), b3, voffB);
            PG8_BAR; PG8_WAIT_L(0); PG8_MMA(0, 1, At, B1); PG8_BAR;
            PG8_LDA(At, 1, 1); PG8_STAGE(PG8_SA(1, 0), a3, voffA);
            PG8_BAR; PG8_WAIT_L(0); PG8_MMA(1, 0, At, B0); PG8_BAR; PG8_SCHED;
            PG8_STAGE(PG8_SB(1, 1), b3 + hstep, voffB);
            PG8_WAIT_V(6); PG8_BAR; PG8_MMA(1, 1, At, B1); PG8_BAR;
            }
        }
        if constexpr (ALIGN_EPI) { if (wr == 0) PG8_BAR; }
        if constexpr (!Epi::AFTER_DRAIN) { E(acc, cur, wr, wc, fr, fq); S.done(cur); }
        if (!has_next) break;
#pragma unroll
        for (int a = 0; a < 2; ++a)
#pragma unroll
            for (int b = 0; b < 2; ++b)
#pragma unroll
                for (int m = 0; m < 4; ++m)
#pragma unroll
                    for (int n = 0; n < 2; ++n) acc[a][b][m][n] = (f32x4){0.f, 0.f, 0.f, 0.f};
        cur = nxt; cA = nA; cB = nB; ++ui;
        if constexpr (ALIGN_EPI) { if (wr == 1) PG8_BAR; }
    }
    PG8_WAIT_V(0);
    if constexpr (!ALIGN_EPI) { if (wr == 0) PG8_BAR; }
    PG8_BAR;
    if constexpr (Epi::AFTER_DRAIN) { E.fused(acc, cur, wr, wc, fr, fq, lds, wid, lane); S.done(cur); }
#undef PG8_SA
#undef PG8_SB
#undef PG8_STAGE
#undef PG8_LDA
#undef PG8_LDB
#undef PG8_MMA
#undef PG8_WAIT_V
#undef PG8_WAIT_L
#undef PG8_BAR
#undef PG8_SCHED
}
}
namespace pg8 {
typedef unsigned u32x2 __attribute__((ext_vector_type(2)));
typedef float f32x2v_ __attribute__((ext_vector_type(2))); typedef __bf16 bf16x2v_ __attribute__((ext_vector_type(2)));
__device__ __forceinline__ unsigned cvt2(float lo, float hi) { f32x2v_ v = {lo, hi}; bf16x2v_ b = __builtin_convertvector(v, bf16x2v_); return __builtin_bit_cast(unsigned, b); }
__device__ __forceinline__ float sigmoid_f(float x) { return __builtin_amdgcn_rcpf(1.f + __builtin_amdgcn_exp2f(-1.4426950408889634f * x)); }
__device__ __forceinline__ float silu_f(float x) { return x * sigmoid_f(x); }
__device__ __forceinline__ float gelu_tanh_f(float x) { const float u = 0.7978845608028654f * (x + 0.044715f * x * x * x); return x * sigmoid_f(2.f * u); }
__device__ __forceinline__ float bflo(unsigned w) { return __uint_as_float(w << 16); }
__device__ __forceinline__ float bfhi(unsigned w) { return __uint_as_float(w & 0xffff0000u); }
template <int ACT> __device__ __forceinline__ float act_f(float v) {
    if (ACT == 1) return v * 0.125f; if (ACT == 2) return silu_f(v); if (ACT == 3) return gelu_tanh_f(v); if (ACT == 4) return sigmoid_f(v); return v; }
template <int ACT> __device__ __forceinline__ void store_tile_bf16(const f32x4 (&acc)[2][2][4][2], bf16_t* base, int ld, int row0, int col0) {
#pragma unroll
    for (int ai = 0; ai < 2; ++ai)
#pragma unroll
        for (int m = 0; m < 4; ++m) { bf16_t* rowp = base + (size_t)(row0 + ai * HALF + m * 16) * ld + col0;
#pragma unroll
            for (int bj = 0; bj < 2; ++bj) { const f32x4 v0 = acc[ai][bj][m][0], v1 = acc[ai][bj][m][1]; u32x4 w;
                w.x = cvt2(act_f<ACT>(v0[0]), act_f<ACT>(v0[1])); w.y = cvt2(act_f<ACT>(v0[2]), act_f<ACT>(v0[3]));
                w.z = cvt2(act_f<ACT>(v1[0]), act_f<ACT>(v1[1])); w.w = cvt2(act_f<ACT>(v1[2]), act_f<ACT>(v1[3]));
                *(u32x4*)(rowp + bj * HALF) = w; }
            asm volatile("" ::: "memory"); }
}
struct EpiProj {
    static constexpr bool PERM = true, AFTER_DRAIN = false;
    unsigned char* proj; float* narrow;
    __device__ __forceinline__ void operator()(const f32x4 (&acc)[2][2][4][2], const Unit& u, int wr, int wc, int fr, int fq) const {
        const int row0 = u.pm * BM + wr * 64 + fr; const int pn = u.pn;
        if (pn == 23) {
            if (wc == 0) {
#pragma unroll
                for (int ai = 0; ai < 2; ++ai)
#pragma unroll
                    for (int m = 0; m < 4; ++m) { float* rp = narrow + (size_t)(row0 + ai * HALF + m * 16) * 32 + 8 * fq;
#pragma unroll
                        for (int n = 0; n < 2; ++n) { f32x4 v = acc[ai][0][m][n];
                            if (8 * fq + 4 * n < 24) { v[0] = sigmoid_f(v[0]); v[1] = sigmoid_f(v[1]); v[2] = sigmoid_f(v[2]); v[3] = sigmoid_f(v[3]); }
                            *(f32x4*)(rp + 4 * n) = v; } }
            }
            return;
        }
        size_t fo; int ld, cin, act;
        if (pn < 2) { fo = F_AQ; ld = 512; cin = pn * 256; act = 1; }
        else if (pn < 5) { fo = F_KV; ld = 768; cin = (pn - 2) * 256; act = 0; }
        else { const int f = (pn - 5) >> 1; fo = F_AZ + (size_t)f * (16 * MiB); ld = 512; cin = ((pn - 5) & 1) * 256; act = (int)((0x240002332ull >> (4 * f)) & 0xFull); }
        bf16_t* base = (bf16_t*)(proj + fo); const int col0 = cin + wc * 32 + 8 * fq;
        switch (act) {
            case 0: store_tile_bf16<0>(acc, base, ld, row0, col0); break;
            case 1: store_tile_bf16<1>(acc, base, ld, row0, col0); break;
            case 2: store_tile_bf16<2>(acc, base, ld, row0, col0); break;
            case 3: store_tile_bf16<3>(acc, base, ld, row0, col0); break;
            default: store_tile_bf16<4>(acc, base, ld, row0, col0); break;
        }
    }
};
struct EpiGate {
    static constexpr bool PERM = true, AFTER_DRAIN = false;
    unsigned char* proj;
    __device__ __forceinline__ void operator()(const f32x4 (&acc)[2][2][4][2], const Unit& u, int wr, int wc, int fr, int fq) const {
        const int br = u.pn >> 2; bf16_t* base = (bf16_t*)(proj + (br ? S2 + (size_t)(br - 1) * (S3 - S2) : S1));
        store_tile_bf16<4>(acc, base, 1024, u.pm * BM + wr * 64 + fr, (u.pn & 3) * 256 + wc * 32 + 8 * fq);
    }
};
template <bool FIRST> struct EpiBranch {
    static constexpr bool PERM = true, AFTER_DRAIN = false;
    const bf16_t* G; bf16_t* mg; float scale;
    __device__ __forceinline__ void operator()(const f32x4 (&acc)[2][2][4][2], const Unit& u, int wr, int wc, int fr, int fq) const {
        const int row0 = u.pm * BM + wr * 64 + fr, col0 = u.pn * 256 + wc * 32 + 8 * fq;
#pragma unroll
        for (int ai = 0; ai < 2; ++ai)
#pragma unroll
            for (int m = 0; m < 4; ++m) { const size_t ro = (size_t)(row0 + ai * HALF + m * 16) * 1024 + col0;
#pragma unroll
                for (int bj = 0; bj < 2; ++bj) { const f32x4 v0 = acc[ai][bj][m][0], v1 = acc[ai][bj][m][1];
                    const u32x4 g = *(const u32x4*)(G + ro + bj * HALF);
                    float o[8] = { v0[0] * bflo(g.x), v0[1] * bfhi(g.x), v0[2] * bflo(g.y), v0[3] * bfhi(g.y), v1[0] * bflo(g.z), v1[1] * bfhi(g.z), v1[2] * bflo(g.w), v1[3] * bfhi(g.w) };
#pragma unroll
                    for (int j = 0; j < 8; ++j) o[j] *= scale;
                    if (!FIRST) { const u32x4 p = *(const u32x4*)(mg + ro + bj * HALF);
                        o[0] += bflo(p.x); o[1] += bfhi(p.x); o[2] += bflo(p.y); o[3] += bfhi(p.y); o[4] += bflo(p.z); o[5] += bfhi(p.z); o[6] += bflo(p.w); o[7] += bfhi(p.w); }
                    u32x4 w; w.x = cvt2(o[0], o[1]); w.y = cvt2(o[2], o[3]); w.z = cvt2(o[4], o[5]); w.w = cvt2(o[6], o[7]);
                    *(u32x4*)(mg + ro + bj * HALF) = w; }
                asm volatile("" ::: "memory"); }
    }
};
struct EpiOut {
    static constexpr bool PERM = false, AFTER_DRAIN = false;
    const float* xres; float* out; bf16_t* xb; float alpha;
    __device__ __forceinline__ void operator()(const f32x4 (&acc)[2][2][4][2], const Unit& u, int wr, int wc, int fr, int fq) const {
        const int row0 = u.pm * BM + wr * 64 + fr, col0 = u.pn * 256 + wc * 32 + 4 * fq;
#pragma unroll
        for (int ai = 0; ai < 2; ++ai)
#pragma unroll
            for (int m = 0; m < 4; ++m) { const size_t ro = (size_t)(row0 + ai * HALF + m * 16) * 1024 + col0;
#pragma unroll
                for (int bj = 0; bj < 2; ++bj)
#pragma unroll
                    for (int n = 0; n < 2; ++n) { const size_t o = ro + bj * HALF + n * 16; const f32x4 xi = *(const f32x4*)(xres + o);
                        const f32x4 r = xi * alpha + acc[ai][bj][m][n]; *(f32x4*)(out + o) = r;
                        u32x2 w; w.x = cvt2(r[0], r[1]); w.y = cvt2(r[2], r[3]); *(u32x2*)(xb + o) = w; }
                asm volatile("" ::: "memory"); }
    }
};
struct EpiPw {
    static constexpr bool PERM = true, AFTER_DRAIN = false;
    bf16_t* pw;
    __device__ __forceinline__ void operator()(const f32x4 (&acc)[2][2][4][2], const Unit& u, int wr, int wc, int fr, int fq) const {
        store_tile_bf16<0>(acc, pw, 1024, u.pm * BM + wr * 64 + fr, u.pn * 256 + wc * 32 + 8 * fq);
    }
};
struct EpiPle {
    static constexpr bool PERM = false, AFTER_DRAIN = false;
    float* out; const bf16_t* pw;
    __device__ __forceinline__ void operator()(const f32x4 (&acc)[2][2][4][2], const Unit& u, int wr, int wc, int fr, int fq) const {
        const int row0 = u.pm * BM + wr * 64 + fr, col0 = u.pn * 256 + wc * 32 + 4 * fq;
#pragma unroll
        for (int ai = 0; ai < 2; ++ai)
#pragma unroll
            for (int m = 0; m < 4; ++m) { const size_t ro = (size_t)(row0 + ai * HALF + m * 16) * 1024 + col0;
#pragma unroll
                for (int bj = 0; bj < 2; ++bj)
#pragma unroll
                    for (int n = 0; n < 2; ++n) { const size_t o = ro + bj * HALF + n * 16; f32x4 r = *(const f32x4*)(out + o); const u32x2 p = *(const u32x2*)(pw + o);
                        const f32x4 a = acc[ai][bj][m][n];
                        r[0] += sigmoid_f(a[0]) * bflo(p.x); r[1] += sigmoid_f(a[1]) * bfhi(p.x); r[2] += sigmoid_f(a[2]) * bflo(p.y); r[3] += sigmoid_f(a[3]) * bfhi(p.y);
                        *(f32x4*)(out + o) = r; }
                asm volatile("" ::: "memory"); }
    }
};
}
#define GAS __attribute__((address_space(1)))
#define LAS __attribute__((address_space(3)))
typedef unsigned short bf16;
typedef unsigned v4u __attribute__((ext_vector_type(4)));
typedef float f32x4 __attribute__((ext_vector_type(4)));
typedef short bf16x8 __attribute__((ext_vector_type(8)));
typedef GAS unsigned gu32;
typedef GAS unsigned long long gu64;
#define RLX_AGENT __ATOMIC_RELAXED, __HIP_MEMORY_SCOPE_AGENT
#define LDS_WAIT() asm volatile("s_waitcnt lgkmcnt(0)" ::: "memory")
#define VM_WAIT() asm volatile("s_waitcnt vmcnt(0)" ::: "memory")
__device__ __forceinline__ unsigned long long rt() { return __builtin_amdgcn_s_memrealtime(); }
__device__ __forceinline__ unsigned f2bf(float f) { unsigned u = __builtin_bit_cast(unsigned, f); return (u + 0x7fffu + ((u >> 16) & 1u)) >> 16; }
__device__ __forceinline__ unsigned pk2(float lo, float hi) { return f2bf(lo) | (f2bf(hi) << 16); }
#define XB_TMO      128
#define XB_XCNT(j)  (256  + 64 * (j))
#define XB_XSUB(j)  (1280 + 64 * (j))
#define XB_XGEN(j)  (2304 + 64 * (j))
#define XB_TOP      3328
#define XB_TOPGEN   3392
#define XCD_BAR_WORDS 3456
#define XB_SPIN_CAP (1u << 18)

__device__ __forceinline__ unsigned xb_ld(unsigned* p)              { return __hip_atomic_load(p, __ATOMIC_RELAXED, __HIP_MEMORY_SCOPE_AGENT); }
__device__ __forceinline__ unsigned xb_add(unsigned* p, unsigned v) { return __hip_atomic_fetch_add(p, v, __ATOMIC_RELAXED, __HIP_MEMORY_SCOPE_AGENT); }
__device__ __forceinline__ unsigned xb_xcc_id() { return (unsigned)__builtin_amdgcn_s_getreg((3 << 11) | 20) & 0xFu; }
#define XB_SPIN(cond, bar) do { unsigned _sp = 0; while (cond) { __builtin_amdgcn_s_sleep(1); \
    if ((++_sp & 255u) == 0u) { if (xb_ld(&(bar)[XB_TMO])) break; if (_sp > XB_SPIN_CAP) { atomicAdd(&(bar)[XB_TMO], 1u); break; } } } } while (0)

struct XcdBarrier {
    unsigned* bar; unsigned x;
    volatile LAS unsigned* st;
};

__device__ __forceinline__ XcdBarrier xcd_barrier_post(unsigned* bar, volatile LAS unsigned* st) {
    XcdBarrier b; b.bar = bar; b.x = xb_xcc_id(); b.st = st;
    if (threadIdx.x == 0) (void)xb_add(&bar[XB_XCNT(b.x)], 1u);
    return b;
}
__device__ __forceinline__ void xcd_barrier_complete(unsigned* bar, unsigned x, unsigned& nloc, unsigned& nx) {
    const unsigned G = gridDim.x * gridDim.y * gridDim.z;
    unsigned sum, cnt, mine, sp = 0u;
    for (;;) {
        sum = 0u; cnt = 0u; mine = 0u;
#pragma unroll
        for (unsigned j = 0; j < 16; ++j) { const unsigned c = xb_ld(&bar[XB_XCNT(j)]); sum += c; cnt += (c > 0u) ? 1u : 0u; mine = (j == x) ? c : mine; }
        if (sum == G) break;
        __builtin_amdgcn_s_sleep(1);
        if ((++sp & 255u) == 0u) { if (xb_ld(&bar[XB_TMO])) break; if (sp > XB_SPIN_CAP) { atomicAdd(&bar[XB_TMO], 1u); break; } }
    }
    nloc = mine > 0u ? mine : 1u; nx = cnt > 0u ? cnt : 1u;
}

__device__ __forceinline__ void xcd_barrier(const XcdBarrier& b) {
    asm volatile("s_waitcnt vmcnt(0)" ::: "memory");
    __syncthreads();
    if (threadIdx.x == 0) {
        unsigned* bar = b.bar;
        __builtin_amdgcn_s_waitcnt(0);
        unsigned nloc = b.st[0], nx = b.st[1];
        if (nloc == 0u) { xcd_barrier_complete(bar, b.x, nloc, nx); b.st[0] = nloc; b.st[1] = nx; }
        const unsigned old = xb_add(&bar[XB_XSUB(b.x)], 1u);
        const unsigned gen = old / nloc;
        if (old + 1u == (gen + 1u) * nloc) {
            __builtin_amdgcn_fence(__ATOMIC_RELEASE, "agent");
            asm volatile("s_waitcnt vmcnt(0)" ::: "memory");
            const unsigned og = xb_add(&bar[XB_TOP], 1u);
            const unsigned tg = og / nx;
            if (og + 1u == (tg + 1u) * nx) xb_add(&bar[XB_TOPGEN], 1u);
            else XB_SPIN(xb_ld(&bar[XB_TOPGEN]) == tg, bar);
            __builtin_amdgcn_fence(__ATOMIC_ACQUIRE, "agent");
            xb_add(&bar[XB_XGEN(b.x)], 1u);
            asm volatile("s_waitcnt vmcnt(0)" ::: "memory");
        } else {
            XB_SPIN(xb_ld(&bar[XB_XGEN(b.x)]) == gen, bar);
            __builtin_amdgcn_fence(__ATOMIC_ACQUIRE, "agent");
            asm volatile("s_waitcnt vmcnt(0)" ::: "memory");
        }
    }
    __syncthreads();
}
typedef short v4i16_t __attribute__((ext_vector_type(4)));
typedef unsigned u32x2 __attribute__((ext_vector_type(2)));
typedef float f32x2_t __attribute__((ext_vector_type(2)));
typedef __bf16 bf16x2_t __attribute__((ext_vector_type(2)));
typedef LAS unsigned char* lds_t;
__device__ __forceinline__ unsigned cvtpk(float lo, float hi) { f32x2_t v = {lo, hi}; bf16x2_t b = __builtin_convertvector(v, bf16x2_t); return __builtin_bit_cast(unsigned, b); }
__device__ __forceinline__ float bflo(unsigned w) { return __uint_as_float(w << 16); }
__device__ __forceinline__ float bfhi(unsigned w) { return __uint_as_float(w & 0xffff0000u); }
__device__ __forceinline__ void unpack8(const v4u w, float (&f)[8]) { f[0] = bflo(w.x); f[1] = bfhi(w.x); f[2] = bflo(w.y); f[3] = bfhi(w.y); f[4] = bflo(w.z); f[5] = bfhi(w.z); f[6] = bflo(w.w); f[7] = bfhi(w.w); }
__device__ __forceinline__ v4u pack8(const float (&f)[8]) { v4u w; w.x = cvtpk(f[0], f[1]); w.y = cvtpk(f[2], f[3]); w.z = cvtpk(f[4], f[5]); w.w = cvtpk(f[6], f[7]); return w; }
__device__ __forceinline__ float sigm(float x) { return __builtin_amdgcn_rcpf(1.f + __builtin_amdgcn_exp2f(-L2E * x)); }
__device__ __forceinline__ float siluf(float x) { return x * sigm(x); }
__device__ __forceinline__ float gelut(float x) { const float u = 0.7978845608028654f * (x + 0.044715f * x * x * x); return x * sigm(2.f * u); }
__device__ __forceinline__ f32x4 mfma16(bf16x8 a, bf16x8 b, f32x4 c) { return __builtin_amdgcn_mfma_f32_16x16x32_bf16(a, b, c, 0, 0, 0); }
__device__ __forceinline__ v4i16_t trd(lds_t p) { return __builtin_amdgcn_ds_read_tr16_b64_v4i16((LAS v4i16_t*)p); }
__device__ __forceinline__ bf16x8 tr_pair(lds_t base, int stride, int rowb, int col, int fr, int Q) {
    lds_t p = base + (rowb + 4 * Q + (fr >> 2)) * stride + (col + 4 * (fr & 3)) * 2;
    const v4i16_t a = trd(p), b = trd(p + 16 * stride);
    return (bf16x8){a[0], a[1], a[2], a[3], b[0], b[1], b[2], b[3]};
}
__device__ __forceinline__ bf16x8 mk_frag(u32x2 a, u32x2 b) { v4u w; w.x = a.x; w.y = a.y; w.z = b.x; w.w = b.y; return __builtin_bit_cast(bf16x8, w); }
__device__ __forceinline__ float logsigf(float x) { return fminf(x, 0.f) - log1pf(expf(-fabsf(x))); }
__device__ __forceinline__ const float* ld_ptr(const LAS unsigned long long* t, int k) {
    const unsigned long long v = t[k];
    const unsigned lo = __builtin_amdgcn_readfirstlane((unsigned)v), hi = __builtin_amdgcn_readfirstlane((unsigned)(v >> 32));
    return (const float*)(const GAS float*)(uintptr_t)(((unsigned long long)hi << 32) | lo);
}
__device__ __forceinline__ float wave_sum(float v) {
#pragma unroll
    for (int o = 1; o < 64; o <<= 1) v += __shfl_xor(v, o);
    return v;
}
__device__ __forceinline__ void tr_item(const float* W, int ldw, bf16* WT, int K, int row_off, LAS float* scr, int kb, int nb, int lane) {
    const int k0 = 64 * kb, n0 = 32 * nb;
#pragma unroll 8
    for (int i = 0; i < 32; ++i) { const int kk = 2 * i + (lane >> 5); scr[kk * 33 + (lane & 31)] = W[(size_t)(k0 + kk) * ldw + n0 + (lane & 31)]; }
    LDS_WAIT(); asm volatile("" ::: "memory");
    const int c = lane & 7;
#pragma unroll
    for (int j = 0; j < 4; ++j) { const int n = (lane >> 3) + 8 * j; const LAS float* s = scr + (8 * c) * 33 + n;
        v4u o; o.x = cvtpk(s[0 * 33], s[1 * 33]); o.y = cvtpk(s[2 * 33], s[3 * 33]); o.z = cvtpk(s[4 * 33], s[5 * 33]); o.w = cvtpk(s[6 * 33], s[7 * 33]);
        *(v4u*)(WT + (size_t)(row_off + n0 + n) * K + k0 + 8 * c) = o; }
    LDS_WAIT(); asm volatile("" ::: "memory");
}
__device__ __forceinline__ void cvt_rows(const float* src, bf16* dst, size_t n8, size_t gt, size_t ngt) {
    for (size_t i = gt; i < n8; i += ngt) { const f32x4 a = *(const f32x4*)(src + 8 * i), b = *(const f32x4*)(src + 8 * i + 4);
        v4u o; o.x = cvtpk(a[0], a[1]); o.y = cvtpk(a[2], a[3]); o.z = cvtpk(b[0], b[1]); o.w = cvtpk(b[2], b[3]); *(v4u*)(dst + 8 * i) = o; }
}
__device__ __forceinline__ void conv_layer(const LAS unsigned long long* ptab, unsigned char* ws, int L, lds_t lds, int vcu, int G, int tid, int lane, int wave) {
    LAS float* scr = (LAS float*)(lds + wave * 16384);
    const int gw = vcu * 8 + wave, NGW = G * 8;
    const float* w_in = ld_ptr(ptab, 2) + (size_t)L * 1024 * NIN;
    bf16* WIN = (bf16*)(ws + WS_WIN); bf16* WBR = (bf16*)(ws + WS_WBR);
    constexpr int I0 = 16 * 40, I1 = 16 * 112, I2 = 16 * 32, I3 = 16 * 96, IBR = 8 * 32, IO = 16 * 32, IPW = 4 * 32, IC1 = 32 * 4, IC2 = 2 * 2;
    constexpr int NITEMS = I0 + I1 + I2 + I3 + 3 * IBR + 2 * IO + IPW + 2 * IC1 + 2 * IC2;
#define TR_JOB(Wp, ldw, K, ncols, WTp, roff) { constexpr int ni_ = ((K) / 64) * ((ncols) / 32); if (r < ni_) { tr_item((Wp), (ldw), (WTp), (K), (roff), scr, r / ((ncols) / 32), r % ((ncols) / 32), lane); continue; } r -= ni_; }
    for (int it = gw; it < NITEMS; it += NGW) {
        int r = it;
        TR_JOB(w_in + 0, NIN, 1024, 1280, WIN, 0)
        TR_JOB(w_in + 1304, NIN, 1024, 3584, WIN, 1280)
        TR_JOB(w_in + 4896, NIN, 1024, 1024, WIN, 4864)
        TR_JOB(w_in + 5920, NIN, 1024, 3072, WIN, 6144)
        TR_JOB(ld_ptr(ptab, 18) + (size_t)L * 512 * 1024, 1024, 512, 1024, WBR, 0)
        TR_JOB(ld_ptr(ptab, 19) + (size_t)L * 512 * 1024, 1024, 512, 1024, WBR + 1024 * 512, 0)
        TR_JOB(ld_ptr(ptab, 20) + (size_t)L * 512 * 1024, 1024, 512, 1024, WBR + 2 * 1024 * 512, 0)
        TR_JOB(ld_ptr(ptab, 21) + (size_t)L * 1024 * 1024, 1024, 1024, 1024, (bf16*)(ws + WS_WOUT), 0)
        TR_JOB(ld_ptr(ptab, 23) + (size_t)L * 1024 * 1024, 1024, 1024, 1024, (bf16*)(ws + WS_WPG), 0)
        TR_JOB(ld_ptr(ptab, 22) + (size_t)L * 256 * 1024, 1024, 256, 1024, (bf16*)(ws + WS_WPW), 0)
        TR_JOB(ld_ptr(ptab, 5) + (size_t)L * 2048 * 128, 128, 2048, 128, (bf16*)(ws + WS_CW1), 0)
        TR_JOB(ld_ptr(ptab, 7) + (size_t)L * 2048 * 128, 128, 2048, 128, (bf16*)(ws + WS_CW1) + 128 * 2048, 0)
        TR_JOB(ld_ptr(ptab, 6) + (size_t)L * 128 * 64, 64, 128, 64, (bf16*)(ws + WS_CW2), 0)
        TR_JOB(ld_ptr(ptab, 8) + (size_t)L * 128 * 64, 64, 128, 64, (bf16*)(ws + WS_CW2) + 64 * 128, 0)
    }
#undef TR_JOB
    const size_t gt = (size_t)vcu * 512 + tid, ngt = (size_t)G * 512;
    for (size_t i = gt; i < (size_t)256 * 1024; i += ngt) { const int rr = (int)(i >> 10), k = (int)(i & 1023);
        float v = 0.f; if (rr < 24) v = w_in[(size_t)k * NIN + 1280 + rr]; else if (rr < 32) v = w_in[(size_t)k * NIN + 4888 + (rr - 24)];
        WIN[(size_t)(5888 + rr) * 1024 + k] = (bf16)(cvtpk(v, 0.f) & 0xffffu); }
    { const float* sgw = ld_ptr(ptab, 11) + (size_t)L * 4 * 128 * 128; bf16* o = (bf16*)(ws + WS_SGW);
      for (size_t i = gt; i < (size_t)4 * 128 * 128; i += ngt) { const int s = (int)(i & 127), t = (int)((i >> 7) & 127); const float v = (s <= t) ? sgw[i] : 0.f; o[i] = (bf16)(cvtpk(v, 0.f) & 0xffffu); } }
    cvt_rows(ld_ptr(ptab, 1) + (size_t)L * M * PLE, (bf16*)(ws + WS_PB), (size_t)M * PLE / 8, gt, ngt);
}
__device__ __forceinline__ void ln_row(const float* xrow, float* orow, bf16* brow, const float* g, const float* bta, int lane) {
    const f32x4* xr = (const f32x4*)xrow + lane;
    f32x4 v[4]; float s = 0.f;
#pragma unroll
    for (int j = 0; j < 4; ++j) { v[j] = xr[64 * j]; s += (v[j][0] + v[j][1]) + (v[j][2] + v[j][3]); }
    const float mean = wave_sum(s) * (1.f / 1024.f); float s2 = 0.f;
#pragma unroll
    for (int j = 0; j < 4; ++j) { v[j] = v[j] - mean; s2 += (v[j][0] * v[j][0] + v[j][1] * v[j][1]) + (v[j][2] * v[j][2] + v[j][3] * v[j][3]); }
    const float rstd = 1.f / sqrtf(wave_sum(s2) * (1.f / 1024.f) + LN_EPS);
#pragma unroll
    for (int j = 0; j < 4; ++j) { const f32x4 gg = *((const f32x4*)g + lane + 64 * j), bb = *((const f32x4*)bta + lane + 64 * j);
        const f32x4 o = v[j] * rstd * gg + bb; *((f32x4*)orow + lane + 64 * j) = o;
        u32x2 w; w.x = cvtpk(o[0], o[1]); w.y = cvtpk(o[2], o[3]); *((u32x2*)brow + lane + 64 * j) = w; }
}
constexpr int TS = 288;
constexpr int TILE_B = 128 * TS;

template <bool DRY> __device__ __forceinline__ void gmlp_item(lds_t lds, int item, bf16* BU, const bf16* BV, const bf16* BZ, const float* lng, const float* lnb, const bf16* sgw, const float* sgb,
                                          int tid, int lane, int wave) {
    const int g = item & 3, c = (item >> 2) & 15, b = item >> 6;
    const size_t tok0 = (size_t)b * T + c * 128;
    LAS float* stats = (LAS float*)(lds + 40960);
    {
        const int s = tid >> 2, part = tid & 3; const bf16* p = BV + (tok0 + s) * 512 + part * 128; float sum = 0.f, sq = 0.f;
#pragma unroll
        for (int i = 0; i < 16; ++i) { const v4u w = *(const v4u*)(p + 8 * i); float f[8]; unpack8(w, f);
#pragma unroll
            for (int j = 0; j < 8; ++j) { sum += f[j]; sq += f[j] * f[j]; } }
        sum += __shfl_xor(sum, 1); sum += __shfl_xor(sum, 2); sq += __shfl_xor(sq, 1); sq += __shfl_xor(sq, 2);
        const float mean = sum * (1.f / 512.f), var = fmaxf(sq * (1.f / 512.f) - mean * mean, 0.f);
        if (part == 0) { stats[2 * s] = mean; stats[2 * s + 1] = 1.f / sqrtf(var + LN_EPS); }
    }
    __syncthreads();
#pragma unroll
    for (int i = 0; i < 4; ++i) {
        const int idx = tid + 512 * i, s = idx >> 4, ch = idx & 15; const int col = g * 128 + 8 * ch;
        const v4u w = *(const v4u*)(BV + (tok0 + s) * 512 + col); float f[8]; unpack8(w, f);
        const float mean = stats[2 * s], rstd = stats[2 * s + 1];
        const f32x4 g0 = *(const f32x4*)(lng + col), g1 = *(const f32x4*)(lng + col + 4), b0 = *(const f32x4*)(lnb + col), b1 = *(const f32x4*)(lnb + col + 4);
#pragma unroll
        for (int j = 0; j < 4; ++j) { f[j] = (f[j] - mean) * rstd * g0[j] + b0[j]; f[4 + j] = (f[4 + j] - mean) * rstd * g1[j] + b1[j]; }
        *(LAS v4u*)(lds + s * TS + ch * 16) = pack8(f);
    }
    __syncthreads();
    const int fr = lane & 15, Q = lane >> 4, tl = 16 * wave + fr;
    f32x4 acc[8];
#pragma unroll
    for (int n = 0; n < 8; ++n) acc[n] = (f32x4){0.f, 0.f, 0.f, 0.f};
    const bf16* wrow = sgw + (size_t)(g * 128 + tl) * 128;
    const int nk = (wave >> 1) + 1;
    for (int kk = 0; kk < nk; ++kk) {
        const u32x2 b0 = *(const u32x2*)(wrow + 32 * kk + 4 * Q), b1 = *(const u32x2*)(wrow + 32 * kk + 16 + 4 * Q);
        const bf16x8 bfr = mk_frag(b0, b1);
#pragma unroll
        for (int n = 0; n < 8; ++n) acc[n] = mfma16(tr_pair(lds, TS, 32 * kk, 16 * n, fr, Q), bfr, acc[n]);
    }
    const float bias = sgb[g * 128 + tl]; const size_t tok = tok0 + tl;
#pragma unroll
    for (int n = 0; n < 8; ++n) { const size_t off = tok * 512 + g * 128 + 16 * n + 4 * Q;
        const u32x2 u = *(const u32x2*)(BU + off), z = *(const u32x2*)(BZ + off);
        u32x2 w; w.x = cvtpk(bflo(u.x) * (acc[n][0] + bias) * bflo(z.x), bfhi(u.x) * (acc[n][1] + bias) * bfhi(z.x));
        w.y = cvtpk(bflo(u.y) * (acc[n][2] + bias) * bflo(z.y), bfhi(u.y) * (acc[n][3] + bias) * bfhi(z.y));
        if (DRY) asm volatile("" :: "v"(w.x), "v"(w.y)); else *(u32x2*)(BU + off) = w; }
    __syncthreads();
}

__device__ __forceinline__ void mlstm_gates(LAS float* garr, const float* narrow, size_t tok0, int h, float bi, float bfo, int lane) {
    const float* p0 = narrow + (tok0 + 2 * lane) * 32;
    const float li0 = p0[24 + h] + bi, li1 = p0[32 + 24 + h] + bi;
    const float lf0 = logsigf(p0[28 + h] + bfo), lf1 = logsigf(p0[32 + 28 + h] + bfo);
    const float c1 = lf0 + lf1; float run = c1;
#pragma unroll
    for (int o = 1; o < 64; o <<= 1) { const float t = __shfl_up(run, o); if (lane >= o) run += t; }
    const float ex = run - c1, bc0 = ex + lf0, bc1 = ex + c1;
    const float a0 = li0 - bc0, a1 = li1 - bc1; const float m1 = fmaxf(a0, a1); float rm = m1;
#pragma unroll
    for (int o = 1; o < 64; o <<= 1) { const float t = __shfl_up(rm, o); if (lane >= o) rm = fmaxf(rm, t); }
    float pe = __shfl_up(rm, 1); if (lane == 0) pe = -INFINITY;
    garr[2 * lane] = bc0; garr[2 * lane + 1] = bc1; garr[128 + 2 * lane] = a0; garr[128 + 2 * lane + 1] = a1;
    garr[256 + 2 * lane] = fmaxf(pe, a0); garr[256 + 2 * lane + 1] = rm;
}
__device__ __forceinline__ void stage_conv(lds_t dst, const bf16* src, size_t tok0, int tin0, int h, const float* cw, const float* cb, float scale, int tid) {
    const int ch = tid & 15, col = h * 128 + 8 * ch;
    float w[4][8], bb[8];
#pragma unroll
    for (int wi = 0; wi < 4; ++wi) { const f32x4 x0 = *(const f32x4*)(cw + wi * 1024 + col), x1 = *(const f32x4*)(cw + wi * 1024 + col + 4);
#pragma unroll
        for (int j = 0; j < 4; ++j) { w[wi][j] = x0[j]; w[wi][4 + j] = x1[j]; } }
    { const f32x4 x0 = *(const f32x4*)(cb + col), x1 = *(const f32x4*)(cb + col + 4);
#pragma unroll
      for (int j = 0; j < 4; ++j) { bb[j] = x0[j]; bb[4 + j] = x1[j]; } }
#pragma unroll
    for (int i = 0; i < 4; ++i) { const int s = (tid >> 4) + 32 * i; float a[8];
#pragma unroll
        for (int j = 0; j < 8; ++j) a[j] = bb[j];
#pragma unroll
        for (int wi = 0; wi < 4; ++wi) { const int ts = s - 3 + wi; const bool ok = tin0 + ts >= 0;
            const v4u x = *(const v4u*)(src + (size_t)((long)tok0 + (ok ? ts : 0)) * 512 + col); float f[8]; unpack8(x, f);
            const float m = ok ? 1.f : 0.f;
#pragma unroll
            for (int j = 0; j < 8; ++j) a[j] += (w[wi][j] * m) * f[j]; }
#pragma unroll
        for (int j = 0; j < 8; ++j) a[j] = siluf(a[j]) * scale;
        *(LAS v4u*)(dst + s * TS + ch * 16) = pack8(a); }
}

__device__ __forceinline__ void mlstm1_item(lds_t lds, int item, const bf16* CK, const bf16* CV, const float* narrow, const float* cw, const float* cb, const float* b_i, const float* b_f,
                                            bf16* cloc, float* nloc, float* msc, int tid, int lane, int wave) {
    const int c = item & 15, h = (item >> 4) & 3, b = item >> 6;
    const size_t tok0 = (size_t)b * T + c * 128;
    lds_t Ks = lds, Vs = lds + TILE_B; LAS float* garr = (LAS float*)(lds + 2 * TILE_B); LAS float* red = garr + 384;
    if (wave == 0) mlstm_gates(garr, narrow, tok0, h, b_i[h], b_f[h], lane);
    stage_conv(Ks, CK, tok0, c * 128, h, cw + 512, cb + 512, 0.08838834764831845f, tid);
    __syncthreads();
    const float pm = garr[256 + 127], bl = garr[127];
#pragma unroll
    for (int i = 0; i < 4; ++i) { const int idx = tid + 512 * i, s = idx >> 4, ch = idx & 15;
        const float e = expf(garr[128 + s] - pm);
        const v4u x = *(const v4u*)(CV + (tok0 + s) * 512 + h * 128 + 8 * ch); float f[8]; unpack8(x, f);
#pragma unroll
        for (int j = 0; j < 8; ++j) f[j] *= e;
        *(LAS v4u*)(Vs + s * TS + ch * 16) = pack8(f); }
    {
        const int k = tid & 127, part = tid >> 7; float sacc = 0.f;
        for (int s = 32 * part; s < 32 * part + 32; ++s) { const float e = expf(garr[128 + s] - pm); const unsigned short kv = *(const LAS unsigned short*)(Ks + s * TS + k * 2); sacc += e * __uint_as_float((unsigned)kv << 16); }
        red[part * 128 + k] = sacc;
    }
    __syncthreads();
    const int fr = lane & 15, Q = lane >> 4;
    f32x4 acc[8];
#pragma unroll
    for (int n = 0; n < 8; ++n) acc[n] = (f32x4){0.f, 0.f, 0.f, 0.f};
#pragma unroll
    for (int kk = 0; kk < 4; ++kk) { const bf16x8 bfr = tr_pair(Vs, TS, 32 * kk, 16 * wave, fr, Q);
#pragma unroll
        for (int kt = 0; kt < 8; ++kt) acc[kt] = mfma16(tr_pair(Ks, TS, 32 * kk, 16 * kt, fr, Q), bfr, acc[kt]); }
    { const int v = 16 * wave + fr; bf16* dst = cloc + ((size_t)item * 128 + v) * 128;
#pragma unroll
      for (int kt = 0; kt < 8; ++kt) { u32x2 w; w.x = cvtpk(acc[kt][0], acc[kt][1]); w.y = cvtpk(acc[kt][2], acc[kt][3]); *(u32x2*)(dst + 16 * kt + 4 * Q) = w; } }
    if (tid < 128) nloc[(size_t)item * 128 + tid] = (red[tid] + red[128 + tid]) + (red[256 + tid] + red[384 + tid]);
    if (tid == 0) { msc[2 * item] = bl + pm; msc[2 * item + 1] = bl; }
    __syncthreads();
}

template <bool DRY> __device__ __forceinline__ void mlstm3_item(lds_t lds, int item, const bf16* CQ, const bf16* CK, const bf16* CV, const bf16* CO, bf16* CZ, const float* narrow, const float* cw, const float* cb,
                                            const float* b_i, const float* b_f, const float* norm_g, const bf16* cloc, const float* nloc, const float* msc, int tid, int lane, int wave) {
    const int c = item & 15, h = (item >> 4) & 3, b = item >> 6, bh = item >> 4;
    const size_t tok0 = (size_t)b * T + c * 128;
    lds_t Qs = lds, Ks = lds + TILE_B, Vs = lds + 2 * TILE_B, Cp = lds + 3 * TILE_B; LAS float* garr = (LAS float*)(lds + 4 * TILE_B); LAS float* npv = garr + 384;
    LAS float* mscl = npv + 128;
    LAS float* wts = mscl + 32;
    if (tid < 32) mscl[tid] = msc[(size_t)bh * 32 + tid];
    if (wave == 0) mlstm_gates(garr, narrow, tok0, h, b_i[h], b_f[h], lane);
    stage_conv(Qs, CQ, tok0, c * 128, h, cw, cb, 1.0f, tid);
    stage_conv(Ks, CK, tok0, c * 128, h, cw + 512, cb + 512, 0.08838834764831845f, tid);
#pragma unroll
    for (int i = 0; i < 4; ++i) { const int idx = tid + 512 * i, s = idx >> 4, ch = idx & 15;
        *(LAS v4u*)(Vs + s * TS + ch * 16) = *(const v4u*)(CV + (tok0 + s) * 512 + h * 128 + 8 * ch); }
    __syncthreads();
    float mp = 0.f;
    for (int j = 0; j < c; ++j) mp = fmaxf(mscl[2 * j + 1] + mp, mscl[2 * j]);
    if (tid < 16) {
        float S = 0.f; for (int i = tid + 1; i < c; ++i) S += mscl[2 * i + 1];
        wts[tid] = (tid < c) ? expf(S + mscl[2 * tid] - mp) : 0.f; }
    __syncthreads();
    {   float a[4][8];
#pragma unroll
        for (int i = 0; i < 4; ++i)
#pragma unroll
            for (int q = 0; q < 8; ++q) a[i][q] = 0.f;
        const bf16* cbase = cloc + (size_t)bh * 16 * 128 * 128;
        for (int j0 = 0; j0 < c; j0 += 4) {
            v4u x[4][4];
#pragma unroll
            for (int jj = 0; jj < 4; ++jj) { const int j = (j0 + jj < c) ? j0 + jj : c - 1;
#pragma unroll
                for (int i = 0; i < 4; ++i) { const int idx = tid + 512 * i; x[jj][i] = *(const v4u*)(cbase + (size_t)j * 16384 + (size_t)(idx >> 4) * 128 + 8 * (idx & 15)); } }
#pragma unroll
            for (int jj = 0; jj < 4; ++jj) { const float w = (j0 + jj < c) ? wts[j0 + jj] : 0.f;
#pragma unroll
                for (int i = 0; i < 4; ++i) { float f[8]; unpack8(x[jj][i], f);
#pragma unroll
                    for (int q = 0; q < 8; ++q) a[i][q] += w * f[q]; } }
        }
#pragma unroll
        for (int i = 0; i < 4; ++i) { const int idx = tid + 512 * i; *(LAS v4u*)(Cp + (idx >> 4) * TS + (idx & 15) * 16) = pack8(a[i]); }
    }
    if (tid < 128) { float a = 0.f;
        for (int j = 0; j < c; ++j) a += wts[j] * nloc[(size_t)(bh * 16 + j) * 128 + tid];
        npv[tid] = a; }
    __syncthreads();
    int lane2 = lane; asm volatile("" : "+v"(lane2));
    const int fr = lane2 & 15, Q = lane2 >> 4, t = 16 * wave + fr;
    const float Mt = fmaxf(mp, garr[256 + t]), eint = expf(mp - Mt), emt = expf(-garr[t] - Mt);
    bf16x8 qf[4];
#pragma unroll
    for (int kk = 0; kk < 4; ++kk) qf[kk] = *(const LAS bf16x8*)(Qs + t * TS + (32 * kk + 8 * Q) * 2);
    unsigned pk[8][2]; float den = 0.f;
#pragma unroll
    for (int st = 0; st < 8; ++st) {
        if (st <= wave) {
            f32x4 sa = (f32x4){0.f, 0.f, 0.f, 0.f};
#pragma unroll
            for (int kk = 0; kk < 4; ++kk) sa = mfma16(*(const LAS bf16x8*)(Ks + (16 * st + fr) * TS + (32 * kk + 8 * Q) * 2), qf[kk], sa);
            float p[4];
#pragma unroll
            for (int r = 0; r < 4; ++r) { const int s = 16 * st + 4 * Q + r; p[r] = (s <= t) ? sa[r] * expf(garr[128 + s] - Mt) : 0.f; den += p[r]; }
            pk[st][0] = cvtpk(p[0], p[1]); pk[st][1] = cvtpk(p[2], p[3]);
        } else { pk[st][0] = 0u; pk[st][1] = 0u; }
    }
    f32x4 a1[8], a2[8];
#pragma unroll
    for (int n = 0; n < 8; ++n) { a1[n] = (f32x4){0.f, 0.f, 0.f, 0.f}; a2[n] = (f32x4){0.f, 0.f, 0.f, 0.f}; }
#pragma unroll
    for (int kk = 0; kk < 4; ++kk) {
        if (2 * kk <= wave) { v4u w; w.x = pk[2 * kk][0]; w.y = pk[2 * kk][1]; w.z = pk[2 * kk + 1][0]; w.w = pk[2 * kk + 1][1]; const bf16x8 bfr = __builtin_bit_cast(bf16x8, w);
#pragma unroll
            for (int vt = 0; vt < 8; ++vt) a1[vt] = mfma16(tr_pair(Vs, TS, 32 * kk, 16 * vt, fr, Q), bfr, a1[vt]); }
    }
    float dint = 0.f;
#pragma unroll
    for (int kk = 0; kk < 4; ++kk) {
#pragma unroll
        for (int vt = 0; vt < 8; ++vt) a2[vt] = mfma16(*(const LAS bf16x8*)(Cp + (16 * vt + fr) * TS + (32 * kk + 8 * Q) * 2), qf[kk], a2[vt]);
        float f[8]; unpack8(__builtin_bit_cast(v4u, qf[kk]), f);
#pragma unroll
        for (int j = 0; j < 8; ++j) dint += npv[32 * kk + 8 * Q + j] * f[j];
    }
    den += __shfl_xor(den, 16); den += __shfl_xor(den, 32); dint += __shfl_xor(dint, 16); dint += __shfl_xor(dint, 32);
    const float dtot = den + eint * dint; const float rden = 1.f / fmaxf(fabsf(dtot), emt);
    float sum = 0.f;
#pragma unroll
    for (int vt = 0; vt < 8; ++vt)
#pragma unroll
        for (int r = 0; r < 4; ++r) { a1[vt][r] = (a1[vt][r] + eint * a2[vt][r]) * rden; sum += a1[vt][r]; }
    sum += __shfl_xor(sum, 16); sum += __shfl_xor(sum, 32);
    const float mu = sum * (1.f / 128.f); float sq = 0.f;
#pragma unroll
    for (int vt = 0; vt < 8; ++vt)
#pragma unroll
        for (int r = 0; r < 4; ++r) { const float d = a1[vt][r] - mu; sq += d * d; }
    sq += __shfl_xor(sq, 16); sq += __shfl_xor(sq, 32);
    const float rstd = 1.f / sqrtf(sq * (1.f / 128.f) + LN_EPS);
    const size_t tok = tok0 + t;
#pragma unroll
    for (int vt = 0; vt < 8; ++vt) { const int col = h * 128 + 16 * vt + 4 * Q; const size_t off = tok * 512 + col;
        const f32x4 ng = *(const f32x4*)(norm_g + col); const u32x2 o = *(const u32x2*)(CO + off), z = *(const u32x2*)(CZ + off);
        u32x2 w; w.x = cvtpk((a1[vt][0] - mu) * rstd * ng[0] * bflo(o.x) * bflo(z.x), (a1[vt][1] - mu) * rstd * ng[1] * bfhi(o.x) * bfhi(z.x));
        w.y = cvtpk((a1[vt][2] - mu) * rstd * ng[2] * bflo(o.y) * bflo(z.y), (a1[vt][3] - mu) * rstd * ng[3] * bfhi(o.y) * bfhi(z.y));
        if (DRY) asm volatile("" :: "v"(w.x), "v"(w.y)); else *(u32x2*)(CZ + off) = w; }
    __syncthreads();
}
__device__ __forceinline__ void cmp_item(lds_t lds, int item, const bf16* KV, const float* posk, const float* posv, const bf16* w1t, const bf16* w2t, bf16* kcmp, bf16* vcmp,
                                         int tid, int lane, int wave) {
    const int nt = item & 7, kv = (item >> 3) & 1, g = (item >> 4) & 1, b = item >> 5;
    const int fr = lane & 15, Q = lane >> 4;
    const float* pos = kv ? posv : posk; const bf16* W1 = w1t + (size_t)kv * 128 * 2048; const bf16* W2 = w2t + (size_t)kv * 64 * 128;
    bf16* outp = (kv ? vcmp : kcmp) + (size_t)((b * 2 + g) * 128) * 64;
    const int n = 16 * nt + fr;
    const bf16* arow = KV + (size_t)b * T * 768 + kv * 128 + g * 64;
    const bf16* brow = W1 + (size_t)(16 * wave + fr) * 2048;
    f32x4 acc = (f32x4){0.f, 0.f, 0.f, 0.f};
#pragma unroll 4
    for (int ks = 0; ks < 64; ++ks) { const int l = ks >> 1, d0 = 32 * (ks & 1) + 8 * Q;
        int tk = 16 * n + l; tk = tk > T - 1 ? T - 1 : tk;
        const v4u x = *(const v4u*)(arow + (size_t)tk * 768 + d0); float f[8]; unpack8(x, f);
        const f32x4 p0 = *(const f32x4*)(pos + l * 64 + d0), p1 = *(const f32x4*)(pos + l * 64 + d0 + 4);
#pragma unroll
        for (int j = 0; j < 4; ++j) { f[j] += p0[j]; f[4 + j] += p1[j]; }
        const bf16x8 afr = __builtin_bit_cast(bf16x8, pack8(f));
        const bf16x8 bfr = *(const bf16x8*)(brow + 32 * ks + 8 * Q);
        acc = mfma16(afr, bfr, acc); }
#pragma unroll
    for (int r = 0; r < 4; ++r) { const unsigned hv = cvtpk(gelut(acc[r]), 0.f); *(LAS unsigned short*)(lds + (4 * Q + r) * 272 + (16 * wave + fr) * 2) = (unsigned short)(hv & 0xffffu); }
    __syncthreads();
    if (wave < 4) {
        f32x4 o = (f32x4){0.f, 0.f, 0.f, 0.f};
#pragma unroll
        for (int kk = 0; kk < 4; ++kk) { const bf16x8 afr = *(const LAS bf16x8*)(lds + fr * 272 + (32 * kk + 8 * Q) * 2);
            const bf16x8 bfr = *(const bf16x8*)(W2 + (size_t)(16 * wave + fr) * 128 + 32 * kk + 8 * Q);
            o = mfma16(afr, bfr, o); }
#pragma unroll
        for (int r = 0; r < 4; ++r) { const int nn = 16 * nt + 4 * Q + r; const float v = (nn < 127) ? o[r] : 0.f;
            outp[(size_t)nn * 64 + 16 * wave + fr] = (bf16)(cvtpk(v, 0.f) & 0xffffu); }
    }
    __syncthreads();
}

constexpr int VS = 160;
constexpr int NSA_WAVE_LDS = 64 * VS;
struct NsaCtx { int fr, Q, tq, t0, cur; unsigned selmask; lds_t wl; };
__device__ __forceinline__ void nsa_scores(f32x4 (&st)[4], const bf16x8 (&kf)[4][2], const bf16x8 (&q)[2]) {
#pragma unroll
    for (int kt = 0; kt < 4; ++kt) { st[kt] = mfma16(kf[kt][0], q[0], (f32x4){0.f, 0.f, 0.f, 0.f}); st[kt] = mfma16(kf[kt][1], q[1], st[kt]); }
}
template <int MODE> __device__ __forceinline__ bool nsa_valid(const NsaCtx& c, int key, int& dist) {
    if (MODE == 0) { dist = c.tq - (16 * key + 31); return dist >= 0; }
    dist = c.tq - key;
    if (MODE == 1) return dist >= 0;
    return dist >= 0 && dist < 256;
}
template <int MODE, int NHH> __device__ __forceinline__ void nsa_pass1(const NsaCtx& c, const bf16* Kb, int ld, int j_lo, int j_hi, const bf16x8 (&qf)[NHH][2], const float (&slope2)[NHH],
                                                                       float (&mrun)[NHH], float (&inv)[NHH]) {
    const int fr = c.fr, Q = c.Q;
    float lrun[NHH];
#pragma unroll
    for (int h = 0; h < NHH; ++h) { mrun[h] = -1e30f; lrun[h] = 0.f; }
#pragma unroll 1
    for (int j = j_lo; j <= j_hi; ++j) {
        if (MODE == 1) { if (!__any((int)((c.selmask >> j) & 1u))) continue; }
        const bool blk_ok = (MODE != 1) || ((c.selmask >> j) & 1u);
        const int key0 = 64 * j;
        bf16x8 kf[4][2];
#pragma unroll
        for (int kt = 0; kt < 4; ++kt)
#pragma unroll
            for (int ks = 0; ks < 2; ++ks) kf[kt][ks] = *(const bf16x8*)(Kb + (size_t)(key0 + 16 * kt + fr) * ld + 32 * ks + 8 * Q);
#pragma unroll
        for (int h = 0; h < NHH; ++h) { f32x4 st[4]; nsa_scores(st, kf, qf[h]);
            float sc[16]; float mx = -1e30f;
#pragma unroll
            for (int kt = 0; kt < 4; ++kt)
#pragma unroll
                for (int r = 0; r < 4; ++r) { int dist; const bool ok = nsa_valid<MODE>(c, key0 + 16 * kt + 4 * Q + r, dist) && blk_ok;
                    const float v = ok ? (st[kt][r] * L2E - slope2[h] * (float)dist) : -1e30f; sc[4 * kt + r] = v; mx = fmaxf(mx, v); }
            const float mn = fmaxf(mrun[h], mx); float s = 0.f;
#pragma unroll
            for (int i = 0; i < 16; ++i) s += (sc[i] > -1e29f) ? __builtin_amdgcn_exp2f(sc[i] - mn) : 0.f;
            lrun[h] = lrun[h] * __builtin_amdgcn_exp2f(mrun[h] - mn) + s; mrun[h] = mn; }
    }
#pragma unroll
    for (int h = 0; h < NHH; ++h) { float mt = fmaxf(mrun[h], __shfl_xor(mrun[h], 16)); mt = fmaxf(mt, __shfl_xor(mt, 32));
        float l = lrun[h] * __builtin_amdgcn_exp2f(mrun[h] - mt); l += __shfl_xor(l, 16); l += __shfl_xor(l, 32);
        mrun[h] = mt; inv[h] = 1.f / fmaxf(l, 1e-30f); }
}
template <int MODE, int NHH, bool IMP, bool PV> __device__ __forceinline__ void nsa_pass2(const NsaCtx& c, const bf16* Kb, const bf16* Vb, int ld, int j_lo, int j_hi, const bf16x8 (&qf)[NHH][2],
        const float (&slope2)[NHH], const float (&mrun)[NHH], const float (&inv)[NHH], const float (&gate)[NHH], f32x4 (&oacc)[NHH][4], float (&imp)[8], int lane) {
    const int fr = c.fr, Q = c.Q;
#pragma unroll 1
    for (int j = j_lo; j <= j_hi; ++j) {
        if (MODE == 1) { if (!__any((int)((c.selmask >> j) & 1u))) continue; }
        const bool blk_ok = (MODE != 1) || ((c.selmask >> j) & 1u);
        const int key0 = 64 * j;
        bf16x8 kf[4][2];
#pragma unroll
        for (int kt = 0; kt < 4; ++kt)
#pragma unroll
            for (int ks = 0; ks < 2; ++ks) kf[kt][ks] = *(const bf16x8*)(Kb + (size_t)(key0 + 16 * kt + fr) * ld + 32 * ks + 8 * Q);
        if (PV) {
            asm volatile("" ::: "memory");
#pragma unroll
            for (int i = 0; i < 8; ++i) { const int row = (lane >> 3) + 8 * i, cc = lane & 7;
                *(LAS v4u*)(c.wl + row * VS + cc * 16) = *(const v4u*)(Vb + (size_t)(key0 + row) * ld + 8 * cc); }
            asm volatile("s_waitcnt lgkmcnt(0)" ::: "memory");
        }
#pragma unroll
        for (int h = 0; h < NHH; ++h) { f32x4 st[4]; nsa_scores(st, kf, qf[h]);
            unsigned pk[4][2]; const float cf = inv[h] * gate[h];
#pragma unroll
            for (int kt = 0; kt < 4; ++kt) { float p[4];
#pragma unroll
                for (int r = 0; r < 4; ++r) { int dist; const bool ok = nsa_valid<MODE>(c, key0 + 16 * kt + 4 * Q + r, dist) && blk_ok;
                    p[r] = ok ? __builtin_amdgcn_exp2f(st[kt][r] * L2E - slope2[h] * (float)dist - mrun[h]) : 0.f; }
                if (IMP) {
                    const int Tt = 4 * j + kt; const float pn3 = p[3] * inv[h]; const float own = ((p[0] + p[1]) + (p[2] + p[3])) * inv[h];
                    const float recv = __shfl(pn3, (lane + 48) & 63);
#pragma unroll
                    for (int tt = 0; tt < 8; ++tt) { if (tt == Tt) imp[tt] += own + (Q > 0 ? recv : 0.f); if (tt == Tt + 1) imp[tt] += (Q == 0 ? recv : 0.f); }
                }
                if (PV) { pk[kt][0] = cvtpk(p[0] * cf, p[1] * cf); pk[kt][1] = cvtpk(p[2] * cf, p[3] * cf); } }
            if (PV) {
#pragma unroll
                for (int kk = 0; kk < 2; ++kk) { v4u w; w.x = pk[2 * kk][0]; w.y = pk[2 * kk][1]; w.z = pk[2 * kk + 1][0]; w.w = pk[2 * kk + 1][1]; const bf16x8 bfr = __builtin_bit_cast(bf16x8, w);
#pragma unroll
                    for (int dt = 0; dt < 4; ++dt) oacc[h][dt] = mfma16(tr_pair(c.wl, VS, 32 * kk, 16 * dt, fr, Q), bfr, oacc[h][dt]); }
            }
        }
        if (PV) asm volatile("s_waitcnt lgkmcnt(0)" ::: "memory");
    }
}
template <bool DRY> __device__ __forceinline__ void nsa_unit(lds_t wl, int b, int g, int qt, const bf16* AQ, const bf16* KV, bf16* AZ, const float* narrow, const bf16* kcmp, const bf16* vcmp, int lane) {
    NsaCtx c; c.fr = lane & 15; c.Q = lane >> 4; c.t0 = 16 * qt; c.tq = c.t0 + c.fr; c.cur = c.t0 >> 6; c.selmask = 0u; c.wl = wl;
    const size_t tokq = (size_t)b * T + c.tq;
    const bf16* kvb = KV + (size_t)b * T * 768 + g * 64;
    const bf16* kcb = kcmp + (size_t)((b * 2 + g) * 128) * 64; const bf16* vcb = vcmp + (size_t)((b * 2 + g) * 128) * 64;
    const int cmp_hi = (c.t0 >= 16) ? (((c.t0 - 16) >> 4) >> 6) : -1;
    const float* gp = narrow + tokq * 32 + g * 4;
    float imp[8];
#pragma unroll
    for (int i = 0; i < 8; ++i) imp[i] = 0.f;
    if (c.cur <= 7) c.selmask = (2u << c.cur) - 1u;
    else {
#pragma unroll 1
        for (int hp = 0; hp < 2; ++hp) {
            const int h0 = 2 * hp;
            bf16x8 qf[2][2]; float slope2[2], mrun[2], inv[2], gate[2]; f32x4 odummy[2][4];
#pragma unroll
            for (int h = 0; h < 2; ++h) { slope2[h] = ldexpf(L2E, -(g * 4 + h0 + h + 1)); gate[h] = 0.f;
#pragma unroll
                for (int ks = 0; ks < 2; ++ks) qf[h][ks] = *(const bf16x8*)(AQ + tokq * 512 + g * 256 + (h0 + h) * 64 + 32 * ks + 8 * c.Q); }
            nsa_pass1<0, 2>(c, kcb, 64, 0, cmp_hi, qf, slope2, mrun, inv);
            nsa_pass2<0, 2, true, false>(c, kcb, vcb, 64, 0, cmp_hi, qf, slope2, mrun, inv, gate, odummy, imp, lane);
        }
        unsigned sel = 1u | (1u << c.cur) | (1u << (c.cur - 1));
        float cand[8];
#pragma unroll
        for (int tt = 0; tt < 8; ++tt) { const int jb = 4 * tt + c.Q; cand[tt] = (jb > 0 && jb < c.cur - 1) ? imp[tt] : -1.f; }
#pragma unroll 1
        for (int it = 0; it < 5; ++it) {
            float bv = cand[0]; int bj = c.Q;
#pragma unroll
            for (int tt = 1; tt < 8; ++tt) if (cand[tt] > bv) { bv = cand[tt]; bj = 4 * tt + c.Q; }
#pragma unroll
            for (int off = 16; off <= 32; off <<= 1) { const float ov = __shfl_xor(bv, off); const int oj = __shfl_xor(bj, off); if (ov > bv || (ov == bv && oj < bj)) { bv = ov; bj = oj; } }
            sel |= 1u << bj;
#pragma unroll
            for (int tt = 0; tt < 8; ++tt) if (4 * tt + c.Q == bj) cand[tt] = -1.f;
        }
        c.selmask = sel;
    }
#pragma unroll 1
    for (int hp = 0; hp < 2; ++hp) {
        const int h0 = 2 * hp;
        bf16x8 qf[2][2]; float slope2[2], mrun[2], inv[2], gate[2]; f32x4 oacc[2][4];
#pragma unroll
        for (int h = 0; h < 2; ++h) { slope2[h] = ldexpf(L2E, -(g * 4 + h0 + h + 1));
#pragma unroll
            for (int ks = 0; ks < 2; ++ks) qf[h][ks] = *(const bf16x8*)(AQ + tokq * 512 + g * 256 + (h0 + h) * 64 + 32 * ks + 8 * c.Q);
#pragma unroll
            for (int dt = 0; dt < 4; ++dt) oacc[h][dt] = (f32x4){0.f, 0.f, 0.f, 0.f}; }
        if (cmp_hi >= 0) {
            gate[0] = gp[h0]; gate[1] = gp[h0 + 1];
            nsa_pass1<0, 2>(c, kcb, 64, 0, cmp_hi, qf, slope2, mrun, inv);
            nsa_pass2<0, 2, false, true>(c, kcb, vcb, 64, 0, cmp_hi, qf, slope2, mrun, inv, gate, oacc, imp, lane);
        }
        gate[0] = gp[8 + h0]; gate[1] = gp[8 + h0 + 1];
        nsa_pass1<1, 2>(c, kvb + 256, 768, 0, c.cur, qf, slope2, mrun, inv);
        nsa_pass2<1, 2, false, true>(c, kvb + 256, kvb + 384, 768, 0, c.cur, qf, slope2, mrun, inv, gate, oacc, imp, lane);
        gate[0] = gp[16 + h0]; gate[1] = gp[16 + h0 + 1];
        { const int lo = c.t0 - 255, jl = (lo > 0 ? lo : 0) >> 6;
          nsa_pass1<2, 2>(c, kvb + 512, 768, jl, c.cur, qf, slope2, mrun, inv);
          nsa_pass2<2, 2, false, true>(c, kvb + 512, kvb + 640, 768, jl, c.cur, qf, slope2, mrun, inv, gate, oacc, imp, lane); }
#pragma unroll
        for (int h = 0; h < 2; ++h)
#pragma unroll
            for (int dt = 0; dt < 4; ++dt) { const size_t off = tokq * 512 + g * 256 + (h0 + h) * 64 + 16 * dt + 4 * c.Q; const u32x2 z = *(const u32x2*)(AZ + off);
                u32x2 w; w.x = cvtpk(oacc[h][dt][0] * bflo(z.x), oacc[h][dt][1] * bfhi(z.x)); w.y = cvtpk(oacc[h][dt][2] * bflo(z.y), oacc[h][dt][3] * bfhi(z.y));
                if (DRY) asm volatile("" :: "v"(w.x), "v"(w.y)); else *(u32x2*)(AZ + off) = w; }
    }
}
#ifndef PHSEL
#define PHSEL -1
#endif
#define PHEN(k) (PHSEL < 0 || PHSEL == (k))
#ifndef DBG_SKIP_GMLP
#define DBG_SKIP_GMLP 0
#endif
#ifndef DUP_MASK
#define DUP_MASK 0
#endif
#ifndef DBG_SKIPMASK
#define DBG_SKIPMASK 0
#endif
#ifndef DBG_NPH
#define DBG_NPH NPHASE
#endif
#define INP(k) ld_ptr(ptab, (k))
struct OneUnit { pg8::Unit u;
    __device__ __forceinline__ bool next(int i, pg8::Unit& o) const { if (i != 0) return false; o = u; return true; }
    __device__ __forceinline__ void a_ready(const pg8::Unit&) const {}
    __device__ __forceinline__ void done(const pg8::Unit&) const {} };
struct Args { const float* in[26]; float* out; unsigned char* ws; int ph_lo, ph_hi; };
static_assert(sizeof(Args) == 26 * 8 + 8 + 8 + 8, "Args has no padding");

__global__ void __launch_bounds__(512, 2) mk_fwd(Args args) {
    extern __shared__ __attribute__((aligned(16))) unsigned char lds_raw[];
    lds_t lds = (lds_t)lds_raw;
    const int tid0 = threadIdx.x;
    const int G0_ = gridDim.x; const int bx0_ = blockIdx.x;
    volatile LAS unsigned* MISC = (volatile LAS unsigned*)(lds + MISC_OFF);
    if (tid0 < 32) MISC[tid0] = 0u;
    LAS unsigned long long* ptab = (LAS unsigned long long*)(lds + MISC_OFF + 256);
    if (tid0 == 0) {
#pragma unroll
        for (int i = 0; i < 26; ++i) ptab[i] = (unsigned long long)(uintptr_t)args.in[i];
    }
    __syncthreads();
    unsigned char* ws0 = args.ws; float* out = args.out;
    gu32* ctl = (gu32*)(ws0 + WS_CTL);
    XcdBarrier bar; bar.bar = (unsigned*)(ctl + CW_BAR); bar.x = 0; bar.st = nullptr;
#if !MK_PER_PHASE
    bar = xcd_barrier_post((unsigned*)(ctl + CW_BAR), MISC + 8);
#endif
    for (int ph = args.ph_lo; ph < args.ph_hi; ++ph) {
        const int L = ph == 0 ? 0 : (ph - 1) >> 3, sub = ph == 0 ? -1 : (ph - 1) & 7;
        int tid = tid0; asm volatile("" : "+v"(tid));
        const int lane = tid & 63, wave = __builtin_amdgcn_readfirstlane(tid >> 6);
        int G = G0_, bx = bx0_; asm volatile("" : "+s"(G), "+s"(bx));
        const int vcu = (G % 8 == 0) ? (bx % 8) * (G / 8) + bx / 8 : bx;
        GAS unsigned char* wsg = (GAS unsigned char*)ws0; asm volatile("" : "+s"(wsg)); unsigned char* ws = (unsigned char*)wsg;
        unsigned char* proj = ws + WS_PROJ;
        bf16* XB = (bf16*)(ws + WS_XB); bf16* PBb = (bf16*)(ws + WS_PB); float* narrow = (float*)(ws + WS_NARROW);
        bf16* WIN = (bf16*)(ws + WS_WIN);
        bf16* AQ = (bf16*)(proj + F_AQ); bf16* KV = (bf16*)(proj + F_KV); bf16* AZ = (bf16*)(proj + F_AZ); bf16* BU = (bf16*)(proj + F_BU); bf16* BV = (bf16*)(proj + F_BV);
        bf16* BZ = (bf16*)(proj + F_BZ); bf16* CQ = (bf16*)(proj + F_CQ); bf16* CK = (bf16*)(proj + F_CK); bf16* CV = (bf16*)(proj + F_CV); bf16* CO = (bf16*)(proj + F_CO);
        bf16* CZ = (bf16*)(proj + F_CZ);
        bf16* G0 = (bf16*)(proj + S1); bf16* G1 = (bf16*)(proj + S2); bf16* G2 = (bf16*)(proj + S3); bf16* MG = (bf16*)(proj + S4); bf16* PW = (bf16*)(proj + S1);
        bf16* kcmp = (bf16*)(ws + WS_KCMP); bf16* vcmp = (bf16*)(ws + WS_VCMP); bf16* cloc = (bf16*)(ws + WS_CLOC); float* nloc = (float*)(ws + WS_NLOC); float* msc = (float*)(ws + WS_MSC);

        if (ph >= NPHASE || ((DBG_SKIPMASK >> ph) & 1)) {
        } else if (ph == 0 && PHEN(0)) {
            cvt_rows(INP(0), XB, (size_t)M * DM / 8, (size_t)vcu * 512 + tid, (size_t)G * 512);
        } else if (sub == 0 && PHEN(1)) {
            pg8::Gemm g{XB, WIN, M, 6144, 1024}; pg8::StaticOrder S; S.init(M, 6144, G, bx);
            pg8::EpiProj E{proj, narrow};
            if (DUP_MASK & 32) pg8::gemm_phase<pg8::EpiProj, pg8::StaticOrder, true, true>(lds, g, S, E);
            pg8::gemm_phase<pg8::EpiProj, pg8::StaticOrder, true, true>(lds, g, S, E);
        } else if (sub == 1 && PHEN(2)) {
            const float* cw = INP(13) + (size_t)L * 4 * 1024; const float* cb = INP(14) + (size_t)L * 1024;
            for (int rep = ((DUP_MASK & 7) ? 0 : 1); rep < 2; ++rep)
            for (int it = bx; it < 256 + 512 + 512; it += G) {
                if (rep == 0) {
                    if (it < 256) { if (DUP_MASK & 1) cmp_item(lds, it, KV, INP(3) + (size_t)L * 32 * 64, INP(4) + (size_t)L * 32 * 64, (const bf16*)(ws + WS_CW1), (const bf16*)(ws + WS_CW2), kcmp, vcmp, tid, lane, wave); }
                    else if (it < 768) { if (DUP_MASK & 2) mlstm1_item(lds, it - 256, CK, CV, narrow, cw, cb, INP(15) + L * 4, INP(16) + L * 4, cloc, nloc, msc, tid, lane, wave); }
                    else { if (DUP_MASK & 4) gmlp_item<true>(lds, it - 768, BU, BV, BZ, INP(9) + (size_t)L * 512, INP(10) + (size_t)L * 512, (const bf16*)(ws + WS_SGW), INP(12) + (size_t)L * 512, tid, lane, wave); }
                    continue; }
                if (it < 256) cmp_item(lds, it, KV, INP(3) + (size_t)L * 32 * 64, INP(4) + (size_t)L * 32 * 64, (const bf16*)(ws + WS_CW1), (const bf16*)(ws + WS_CW2), kcmp, vcmp, tid, lane, wave);
                else if (it < 768) mlstm1_item(lds, it - 256, CK, CV, narrow, cw, cb, INP(15) + L * 4, INP(16) + L * 4, cloc, nloc, msc, tid, lane, wave);
                else if (!DBG_SKIP_GMLP) gmlp_item<false>(lds, it - 768, BU, BV, BZ, INP(9) + (size_t)L * 512, INP(10) + (size_t)L * 512, (const bf16*)(ws + WS_SGW), INP(12) + (size_t)L * 512, tid, lane, wave);
            }
        } else if (sub == 2 && PHEN(3)) {
            const float* cw = INP(13) + (size_t)L * 4 * 1024; const float* cb = INP(14) + (size_t)L * 1024;
#ifndef DBG_NO_ML3
            if (DUP_MASK & 8) for (int it = bx; it < 512; it += G)
                mlstm3_item<true>(lds, it, CQ, CK, CV, CO, CZ, narrow, cw, cb, INP(15) + L * 4, INP(16) + L * 4, INP(17) + (size_t)L * 512, cloc, nloc, msc, tid, lane, wave);
            for (int it = bx; it < 512; it += G)
                mlstm3_item<false>(lds, it, CQ, CK, CV, CO, CZ, narrow, cw, cb, INP(15) + L * 4, INP(16) + L * 4, INP(17) + (size_t)L * 512, cloc, nloc, msc, tid, lane, wave);
#endif
            __syncthreads();
#ifndef DBG_NO_NSA
            if (DUP_MASK & 16) for (int k = 0;; ++k) { const int rho = bx + G * (wave + 8 * k); if (rho >= 2048) break;
                const int qt = 127 - (rho >> 4), bg = rho & 15; int lane_u = lane; asm volatile("" : "+v"(lane_u));
                nsa_unit<true>(lds + wave * NSA_WAVE_LDS, bg >> 1, bg & 1, qt, AQ, KV, AZ, narrow, kcmp, vcmp, lane_u); }
            for (int k = 0;; ++k) { const int rho = bx + G * (wave + 8 * k); if (rho >= 2048) break;
                const int qt = 127 - (rho >> 4), bg = rho & 15;
                int lane_u = lane; asm volatile("" : "+v"(lane_u));
                nsa_unit<false>(lds + wave * NSA_WAVE_LDS, bg >> 1, bg & 1, qt, AQ, KV, AZ, narrow, kcmp, vcmp, lane_u); }
#endif
        } else if (sub == 3 && PHEN(4)) {
            pg8::Gemm g{XB, WIN + (size_t)6144 * 1024, M, 3072, 1024}; pg8::StaticOrder S; S.init(M, 3072, G, bx);
            pg8::EpiGate E{proj};
            if (DUP_MASK & 64) pg8::gemm_phase<pg8::EpiGate, pg8::StaticOrder, true, true>(lds, g, S, E);
            pg8::gemm_phase<pg8::EpiGate, pg8::StaticOrder, true, true>(lds, g, S, E);
        } else if (sub == 4 && PHEN(5)) {
            bf16* WBR = (bf16*)(ws + WS_WBR); pg8::StaticOrder S; S.init(M, 1024, G, bx);
            for (int rep = ((DUP_MASK & 128) ? 0 : 1); rep < 2; ++rep) {
            { pg8::Gemm g{AZ, WBR, M, 1024, 512}; pg8::EpiBranch<true> E{G0, MG, ABL_A}; pg8::gemm_phase<pg8::EpiBranch<true>, pg8::StaticOrder, false, true>(lds, g, S, E); }
            { pg8::Gemm g{BU, WBR + 1024 * 512, M, 1024, 512}; pg8::EpiBranch<false> E{G1, MG, ABL_B}; pg8::gemm_phase<pg8::EpiBranch<false>, pg8::StaticOrder, false, true>(lds, g, S, E); }
            { pg8::Gemm g{CZ, WBR + 2 * 1024 * 512, M, 1024, 512}; pg8::EpiBranch<false> E{G2, MG, ABL_C}; pg8::gemm_phase<pg8::EpiBranch<false>, pg8::StaticOrder, false, true>(lds, g, S, E); }
            }
        } else if (sub == 5 && PHEN(6)) {
            pg8::StaticOrder S; S.init(M, 1024, G, bx);
            { pg8::Gemm g{MG, (const bf16*)(ws + WS_WOUT), M, 1024, 1024}; pg8::EpiOut E{L == 0 ? INP(0) : (const float*)out, out, XB, ALPHA};
              pg8::gemm_phase<pg8::EpiOut, pg8::StaticOrder, false, true>(lds, g, S, E); }
            for (int rep = ((DUP_MASK & 256) ? 0 : 1); rep < 2; ++rep)
            { pg8::Gemm g{PBb, (const bf16*)(ws + WS_WPW), M, 1024, 256}; pg8::EpiPw E{PW}; pg8::gemm_phase<pg8::EpiPw, pg8::StaticOrder, false, true>(lds, g, S, E); }
        } else if (sub == 6 && PHEN(7)) {
            pg8::StaticOrder S; S.init(M, 1024, G, bx);
            pg8::Gemm g{XB, (const bf16*)(ws + WS_WPG), M, 1024, 1024}; pg8::EpiPle E{out, PW};
            pg8::gemm_phase<pg8::EpiPle, pg8::StaticOrder, false, true>(lds, g, S, E);
        } else if (PHEN(8)) {
            const float* lg = INP(24) + (size_t)L * 1024; const float* lb = INP(25) + (size_t)L * 1024;
            for (int m = vcu * 8 + wave; m < M; m += G * 8) ln_row(out + (size_t)m * DM, out + (size_t)m * DM, XB + (size_t)m * DM, lg, lb, lane);
        }
        if ((ph == 0 || ph == 8) && PHEN(0)) {
            int Lv = ph == 0 ? 0 : 1; asm volatile("" : "+v"(Lv)); const int Lc = __builtin_amdgcn_readfirstlane(Lv);
            for (int rep = ((DUP_MASK & 512) ? 0 : 1); rep < 2; ++rep)
            conv_layer(ptab, ws, Lc, lds, vcu, G, tid, lane, wave);
        }
#ifdef DBG_DUMP_OFF
        if (ph == 100) {
            const bf16* src = (const bf16*)(ws + DBG_DUMP_OFF);
            for (size_t i = (size_t)bx * 512 + tid; i < (size_t)M * DM; i += (size_t)G * 512) out[i] = __uint_as_float((unsigned)src[i] << 16);
        }
#endif
#if !MK_PER_PHASE
        if (ph + 1 < args.ph_hi) { XcdBarrier b2 = bar; asm volatile("" : "+s"(b2.bar), "+s"(b2.x)); xcd_barrier(b2); if (DUP_MASK & 1024) xcd_barrier(b2); }
#endif
    }
}

__global__ void fill_const(float* out, int n, float v) { for (int i = blockIdx.x * blockDim.x + threadIdx.x; i < n; i += gridDim.x * blockDim.x) out[i] = v; }

extern "C" void kernel_launch(void* const* d_in, const int* in_sizes, int n_in, void* d_out, int out_size, void* d_ws, size_t ws_size, hipStream_t stream) {
    static int grid = 0;
    if (grid == 0) {
        int dev = 0, cus = 0, per_cu = 0;
        if (n_in != 26 || out_size != M * DM || ws_size < WS_END) { fprintf(stderr, "kernel_launch: unexpected shapes (n_in %d out %d ws %zu, need %zu)\n", n_in, out_size, ws_size, (size_t)WS_END); grid = -1; }
        else if (hipGetDevice(&dev) != hipSuccess || hipDeviceGetAttribute(&cus, hipDeviceAttributeMultiprocessorCount, dev) != hipSuccess) grid = -1;
        else if (hipFuncSetAttribute((const void*)mk_fwd, hipFuncAttributeMaxDynamicSharedMemorySize, LDS_BYTES) != hipSuccess) grid = -1;
        else {
            if (hipOccupancyMaxActiveBlocksPerMultiprocessor(&per_cu, (const void*)mk_fwd, 512, LDS_BYTES) != hipSuccess || per_cu < 1) { fprintf(stderr, "kernel_launch: occupancy query says %d blocks per CU\n", per_cu); per_cu = 0; }
            (void)hipGetLastError();
            grid = per_cu >= 1 ? cus : -1;
        }
    }
    if (grid < 0) {
        hipLaunchKernelGGL(fill_const, dim3(1024), dim3(256), 0, stream, (float*)d_out, out_size, (float)((double)ws_size / 1.0e8));
        return;
    }
    (void)hipMemsetAsync((char*)d_ws + WS_CTL, 0, CTL_ZERO_BYTES, stream);
    Args a{};
    for (int i = 0; i < 26; ++i) a.in[i] = (const float*)d_in[i];
    a.out = (float*)d_out; a.ws = (unsigned char*)d_ws;
#if MK_PER_PHASE
    for (int ph = 0; ph < DBG_NPH; ++ph) { a.ph_lo = ph; a.ph_hi = ph + 1; hipLaunchKernelGGL(mk_fwd, dim3(grid), dim3(512), LDS_BYTES, stream, a); }
#ifdef DBG_DUMP_OFF
    a.ph_lo = 100; a.ph_hi = 101; hipLaunchKernelGGL(mk_fwd, dim3(grid), dim3(512), LDS_BYTES, stream, a);
#endif
#else
    a.ph_lo = 0; a.ph_hi = NPHASE;
    void* kargs[] = {&a};
    const hipError_t e = hipLaunchCooperativeKernel((const void*)mk_fwd, dim3(grid), dim3(512), kargs, LDS_BYTES, stream);
    if (e != hipSuccess) fprintf(stderr, "kernel_launch: cooperative launch failed: %s (grid %d)\n", hipGetErrorString(e), grid);
#endif
}
```
